# Optimizing an MI355X kernel written in HIP

```python
import math
import jax, jax.numpy as jnp
from jax import lax
import numpy as np

D_MODEL = 2048
BATCH = 8
SEQ = 2048
DEPTH = 2

CHUNK = 64
N_META = 16
LEAD = 128
Q_BLOCK = 128
EPS = 1e-6

CONV_DIM = 512
CONV_W = 3
ML_HEADS = 4
ML_DK = 256
ML_DV = 256
ML_DIM = ML_HEADS * ML_DV
DA_HEADS = 4
DA_HD = 64
DA_VD = 2 * DA_HD
DA_DIM = DA_HEADS * DA_VD
D_FF = 5632
FFN_CONV_W = 3
N_BRANCH = 3

D_IN = 3 * CONV_DIM + 2 * ML_HEADS * ML_DK + 2 * ML_DIM + 2 * ML_HEADS + 4 * DA_HEADS * DA_HD + DA_DIM + N_BRANCH * D_MODEL

kernel_name = "hybrid_gated_conv_mlstm_diffattn_encoder"


def _in_split_sizes():
    return (CONV_DIM, CONV_DIM, CONV_DIM,
            ML_HEADS * ML_DK, ML_HEADS * ML_DK, ML_DIM, ML_DIM, ML_HEADS, ML_HEADS,
            DA_HEADS * 2 * DA_HD, DA_HEADS * 2 * DA_HD, DA_DIM,
            D_MODEL, D_MODEL, D_MODEL)


def rmsnorm(x, g):
    xf = x.astype(jnp.float32)
    y = xf * lax.rsqrt(jnp.mean(xf * xf, axis=-1, keepdims=True) + EPS)
    return (y * g.astype(jnp.float32)).astype(x.dtype)


def causal_dwconv(x, w):
    W = w.shape[0]
    L = x.shape[1]
    xp = jnp.pad(x, ((0, 0), (W - 1, 0), (0, 0)))
    y = xp[:, 0:L] * w[0]
    for j in range(1, W):
        y = y + xp[:, j:j + L] * w[j]
    return y


def _pad_lead(t, n):
    return jnp.pad(t, ((0, 0), (n, 0)) + ((0, 0),) * (t.ndim - 2))


def _chunk_ids(n):
    pos = jnp.arange(n)
    return jnp.where(pos < LEAD, 0, 1 + (pos - LEAD) // CHUNK)


def mlstm(q, k, v, i_pre, f_pre):
    padn = LEAD - N_META
    q, k, v, i_pre, f_pre = [_pad_lead(t, padn) for t in (q, k, v, i_pre, f_pre)]
    Bsz, Lp, H, dk = q.shape
    dv = v.shape[-1]
    nc = Lp // CHUNK
    valid = (jnp.arange(Lp) >= padn)[None, :, None]
    log_i = jnp.where(valid, i_pre, -jnp.inf)
    log_f = jnp.where(valid, jax.nn.log_sigmoid(f_pre), 0.0)
    k = k * (dk ** -0.5)

    def to_chunks(t):
        return t.reshape(Bsz, nc, CHUNK, H, t.shape[-1]).transpose(1, 0, 3, 2, 4)

    def gate_chunks(t):
        return t.reshape(Bsz, nc, CHUNK, H).transpose(1, 0, 3, 2)

    tri = jnp.tril(jnp.ones((CHUNK, CHUNK), dtype=bool))

    def step(carry, inp):
        C, n, m = carry
        qc, kc, vc, lic, lfc = inp
        b = jnp.cumsum(lfc, axis=-1)
        D = b[..., :, None] - b[..., None, :] + lic[..., None, :]
        D = jnp.where(tri, D, -jnp.inf)
        inter = b + m[..., None]
        m_t = jnp.maximum(jnp.max(D, axis=-1), inter)
        w = jnp.exp(D - m_t[..., None])
        g = jnp.exp(inter - m_t)
        s = jnp.einsum('bhtd,bhsd->bhts', qc, kc) * w
        num = g[..., None] * jnp.einsum('bhed,bhtd->bhte', C, qc) + jnp.einsum('bhts,bhse->bhte', s, vc)
        den = g * jnp.einsum('bhd,bhtd->bht', n, qc) + jnp.sum(s, axis=-1)
        h = num / jnp.maximum(jnp.abs(den), jnp.exp(-m_t))[..., None]
        bL = b[..., -1]
        ds = bL[..., None] - b + lic
        m_new = jnp.maximum(bL + m, jnp.max(ds, axis=-1))
        wk = jnp.exp(ds - m_new[..., None])
        gs = jnp.exp(bL + m - m_new)
        C = gs[..., None, None] * C + jnp.einsum('bhse,bhsd->bhed', vc * wk[..., None], kc)
        n = gs[..., None] * n + jnp.einsum('bhs,bhsd->bhd', wk, kc)
        return (C, n, m_new), h

    init = (jnp.zeros((Bsz, H, dv, dk), jnp.float32),
            jnp.zeros((Bsz, H, dk), jnp.float32),
            jnp.zeros((Bsz, H), jnp.float32))
    _, hs = lax.scan(step, init, (to_chunks(q), to_chunks(k), to_chunks(v),
                                  gate_chunks(log_i), gate_chunks(log_f)))
    hs = hs.transpose(1, 0, 3, 2, 4).reshape(Bsz, Lp, H, dv)
    return hs[:, padn:]


def diff_attention(q, k, v, lam):
    padn = LEAD - N_META
    q, k, v = [_pad_lead(t, padn) for t in (q, k, v)]
    Lp = q.shape[1]
    cid = _chunk_ids(Lp)
    valid = jnp.arange(Lp) >= padn
    scale = DA_HD ** -0.5
    outs = []
    for j in range(Lp // Q_BLOCK):
        q0 = j * Q_BLOCK
        kend = q0 + Q_BLOCK
        qb = q[:, q0:kend]
        kb = k[:, :kend]
        vb = v[:, :kend]
        s = jnp.einsum('bqhmd,bkhmd->bhmqk', qb, kb).astype(jnp.float32) * scale
        mask = (cid[None, :kend] <= cid[q0:kend, None]) & valid[None, :kend]
        p = jax.nn.softmax(jnp.where(mask, s, -jnp.inf), axis=-1)
        a = p[:, :, 0] - lam * p[:, :, 1]
        outs.append(jnp.einsum('bhqk,bkhe->bqhe', a.astype(v.dtype), vb))
    return jnp.concatenate(outs, axis=1)[:, padn:]


def mixer_block(u, layer, w_in, conv_a, b_if, ml_norm, da_lambda, da_norm, w_br_a, w_br_m, w_br_d, w_out):
    Bsz, L, _ = u.shape
    f32 = jnp.float32
    z = u @ w_in
    idx = np.cumsum(_in_split_sizes())[:-1].tolist()
    (a_x, a_b, a_c, m_q, m_k, m_v, m_o, m_i, m_f,
     d_q, d_k, d_v, g_a, g_m, g_d) = jnp.split(z, idx, axis=-1)
    y_a = (a_b * causal_dwconv(a_c * a_x, conv_a)) @ w_br_a
    hm = mlstm(m_q.reshape(Bsz, L, ML_HEADS, ML_DK).astype(f32),
               m_k.reshape(Bsz, L, ML_HEADS, ML_DK).astype(f32),
               m_v.reshape(Bsz, L, ML_HEADS, ML_DV).astype(f32),
               (m_i + b_if[0]).astype(f32), (m_f + b_if[1]).astype(f32))
    hm = rmsnorm(hm, ml_norm.reshape(ML_HEADS, ML_DV)) * jax.nn.sigmoid(m_o.reshape(Bsz, L, ML_HEADS, ML_DV).astype(f32))
    y_m = hm.reshape(Bsz, L, ML_DIM).astype(u.dtype) @ w_br_m
    lam_init = 0.8 - 0.6 * math.exp(-0.3 * layer)
    lf = da_lambda.astype(f32)
    lam = jnp.exp(jnp.sum(lf[0] * lf[1])) - jnp.exp(jnp.sum(lf[2] * lf[3])) + lam_init
    hd = diff_attention(d_q.reshape(Bsz, L, DA_HEADS, 2, DA_HD),
                        d_k.reshape(Bsz, L, DA_HEADS, 2, DA_HD),
                        d_v.reshape(Bsz, L, DA_HEADS, DA_VD), lam)
    hd = rmsnorm(hd, da_norm) * (1.0 - lam_init)
    y_d = hd.reshape(Bsz, L, DA_DIM) @ w_br_d
    merged = jax.nn.sigmoid(g_a) * y_a + jax.nn.sigmoid(g_m) * y_m + jax.nn.sigmoid(g_d) * y_d
    return merged @ w_out


def channel_mixer(u, w_up, conv_w, conv_b, w_down):
    a, b = jnp.split(u @ w_up, 2, axis=-1)
    a = causal_dwconv(a, conv_w) + conv_b
    return (jax.nn.gelu(a, approximate=False) * b) @ w_down


def setup_inputs(seed: int = 0) -> dict:
    key = jax.random.key(seed)
    ks = jax.random.split(key, 24)
    nrm = lambda k, shape, s: jax.random.normal(k, shape, jnp.float32) * s
    b_if = jnp.stack([nrm(ks[5], (DEPTH, ML_HEADS), 0.1),
                      jnp.linspace(3.0, 6.0, ML_HEADS)[None, :] + nrm(ks[6], (DEPTH, ML_HEADS), 0.1)], axis=1)
    return {
        "x": nrm(ks[0], (BATCH, SEQ, D_MODEL), 1.0),
        "meta": nrm(ks[1], (N_META, D_MODEL), 1.0),
        "norm_mix": 1.0 + nrm(ks[2], (DEPTH, D_MODEL), 0.02),
        "w_in": nrm(ks[3], (DEPTH, D_MODEL, D_IN), D_MODEL ** -0.5),
        "conv_a": nrm(ks[4], (DEPTH, CONV_W, CONV_DIM), CONV_W ** -0.5),
        "b_if": b_if,
        "ml_norm": 1.0 + nrm(ks[7], (DEPTH, ML_DIM), 0.02),
        "da_lambda": nrm(ks[8], (DEPTH, 4, DA_HD), 0.1),
        "da_norm": 1.0 + nrm(ks[9], (DEPTH, DA_VD), 0.02),
        "w_br_a": nrm(ks[10], (DEPTH, CONV_DIM, D_MODEL), CONV_DIM ** -0.5),
        "w_br_m": nrm(ks[11], (DEPTH, ML_DIM, D_MODEL), ML_DIM ** -0.5),
        "w_br_d": nrm(ks[12], (DEPTH, DA_DIM, D_MODEL), DA_DIM ** -0.5),
        "w_out": nrm(ks[13], (DEPTH, D_MODEL, D_MODEL), D_MODEL ** -0.5),
        "norm_ffn": 1.0 + nrm(ks[14], (DEPTH, D_MODEL), 0.02),
        "w_up": nrm(ks[15], (DEPTH, D_MODEL, 2 * D_FF), D_MODEL ** -0.5),
        "conv_ffn": nrm(ks[16], (DEPTH, FFN_CONV_W, D_FF), FFN_CONV_W ** -0.5),
        "conv_ffn_b": nrm(ks[17], (DEPTH, D_FF), 0.02),
        "w_down": nrm(ks[18], (DEPTH, D_FF, D_MODEL), D_FF ** -0.5),
        "norm_f": 1.0 + nrm(ks[19], (D_MODEL,), 0.02),
    }


def reference(x, meta, norm_mix, w_in, conv_a, b_if, ml_norm, da_lambda, da_norm, w_br_a, w_br_m, w_br_d, w_out, norm_ffn, w_up, conv_ffn, conv_ffn_b, w_down, norm_f):
    Bsz = x.shape[0]
    h = jnp.concatenate([jnp.broadcast_to(meta[None].astype(x.dtype), (Bsz, N_META, D_MODEL)), x], axis=1)
    for i in range(DEPTH):
        h = h + mixer_block(rmsnorm(h, norm_mix[i]), i, w_in[i], conv_a[i], b_if[i], ml_norm[i],
                            da_lambda[i], da_norm[i], w_br_a[i], w_br_m[i], w_br_d[i], w_out[i])
        h = h + channel_mixer(rmsnorm(h, norm_ffn[i]), w_up[i], conv_ffn[i], conv_ffn_b[i], w_down[i])
    return rmsnorm(h, norm_f)[:, N_META:]
```

```cpp
#include <hip/hip_runtime.h>
#include <hip/hip_cooperative_groups.h>
#include <cstdio>
namespace cg = cooperative_groups;

#define LAS __attribute__((address_space(3)))
typedef unsigned short bf16_t;
typedef short bf16x8 __attribute__((ext_vector_type(8)));
typedef float f32x4 __attribute__((ext_vector_type(4)));
typedef unsigned u32x4 __attribute__((ext_vector_type(4)));
typedef unsigned u32x2 __attribute__((ext_vector_type(2)));

constexpr int D = 2048, NB = 8, SEQ = 2048, LP = 2112, MP = NB * LP  , PADN = 48, LEADR = 64  ;
constexpr int DIN = 13320, NZ = 13568, NZA = 7168, NZG = 6144;
constexpr int DFF = 5632, NUP = 11264;
constexpr float EPS = 1e-6f;
constexpr int ZA_AX = 0, ZA_AB = 512, ZA_AC = 1024, ZA_MQ = 1536, ZA_MK = 2560, ZA_MV = 3584, ZA_MO = 4608, ZA_DQ = 5632, ZA_DK = 6144, ZA_DV = 6656;
constexpr size_t WS_HP = 0;
constexpr size_t WS_Z = WS_HP + (size_t)MP * D * 4;
constexpr size_t WS_ZG = WS_Z + (size_t)MP * NZA * 2;
constexpr size_t WS_WIN = WS_Z + (size_t)MP * (NZA + NZG) * 2;
constexpr size_t WS_WDOWN = WS_WIN + (size_t)NZ * D * 2;
constexpr size_t WS_GATES = WS_WDOWN + (size_t)D * DFF * 2;
constexpr size_t WS_RSQ = WS_GATES + (size_t)MP * 8 * 4;
constexpr size_t WS_HSQ = WS_RSQ + (size_t)5 * MP * 4;
constexpr size_t WS_GSC = WS_HSQ + (size_t)2 * MP * 4 * 4;
constexpr size_t WS_BAR = WS_GSC + (size_t)256 * 34 * 64 * 16;
constexpr size_t WS_END = WS_BAR + 3456 * 4;
constexpr size_t DO_HB = 0;
constexpr size_t DO_WBR = (size_t)MP * D * 2;
constexpr size_t DO_WOUT = DO_WBR + (size_t)D * D * 2;
constexpr size_t DO_WUP = DO_WOUT + (size_t)D * D * 2;
static_assert(DO_WUP + (size_t)NUP * D * 2 <= (size_t)NB * SEQ * D * 4, "d_out scratch overflow");

constexpr int LDS_BYTES = 152576;
constexpr int LDS_ST = LDS_BYTES - 16;

struct Params {
    const float *x, *meta, *norm_mix, *w_in, *conv_a, *b_if, *ml_norm, *da_lambda, *da_norm, *w_br_a, *w_br_m, *w_br_d, *w_out, *norm_ffn, *w_up, *conv_ffn, *conv_ffn_b, *w_down, *norm_f;
    float* out; unsigned char* ws;
};

typedef const __attribute__((address_space(4))) Params* PP;
__device__ __forceinline__ PP get_params() { unsigned long long kp = (unsigned long long)__builtin_amdgcn_kernarg_segment_ptr(); asm volatile("" : "+s"(kp)); return (PP)kp; }
__device__ __forceinline__ int opaque_tid(int wv) { asm volatile("" : "+s"(wv)); unsigned z = 0u; asm volatile("" : "+v"(z)); const int l = __builtin_amdgcn_mbcnt_hi(~0u, __builtin_amdgcn_mbcnt_lo(~0u, z)); return (wv << 6) | l; }
__device__ __forceinline__ int opaque_bid() { int t = blockIdx.x; asm volatile("" : "+s"(t)); return t; }
__device__ __forceinline__ float shx(float v, int mask, int lane) { return __int_as_float(__builtin_amdgcn_ds_bpermute((lane ^ mask) << 2, __float_as_int(v))); }
__device__ __forceinline__ float shup(float v, int o, int lane) { return __int_as_float(__builtin_amdgcn_ds_bpermute((lane >= o ? lane - o : lane) << 2, __float_as_int(v))); }
__device__ __forceinline__ float shidx(float v, int src) { return __int_as_float(__builtin_amdgcn_ds_bpermute(src << 2, __float_as_int(v))); }
__device__ __forceinline__ u32x2 trr(unsigned addr) { u32x2 r; asm volatile("ds_read_b64_tr_b16 %0, %1" : "=&v"(r) : "v"(addr) : "memory"); return r; }
__device__ __forceinline__ void trw2(u32x2& a, u32x2& b) { asm volatile("s_waitcnt lgkmcnt(0)" : "+v"(a), "+v"(b) : : "memory"); }
__device__ __forceinline__ void trw4(u32x2& a, u32x2& b, u32x2& c, u32x2& d) { asm volatile("s_waitcnt lgkmcnt(0)" : "+v"(a), "+v"(b), "+v"(c), "+v"(d) : : "memory"); }
__device__ __forceinline__ bf16x8 mk8(const u32x2& lo, const u32x2& hi) { u32x4 t; t.x = lo.x; t.y = lo.y; t.z = hi.x; t.w = hi.y; return __builtin_bit_cast(bf16x8, t); }
__device__ __forceinline__ void lds_barrier() { asm volatile("s_waitcnt lgkmcnt(0)" ::: "memory"); __builtin_amdgcn_s_barrier(); asm volatile("" ::: "memory"); }
template <int CTRL> __device__ __forceinline__ float dppmov(float v) { return __builtin_bit_cast(float, __builtin_amdgcn_update_dpp(0, __builtin_bit_cast(int, v), CTRL, 0xF, 0xF, true)); }
__device__ __forceinline__ float row_sum16(float v) { v += dppmov<0xB1>(v); v += dppmov<0x4E>(v); v += dppmov<0x141>(v); v += dppmov<0x140>(v); return v; }
__device__ __forceinline__ u32x4 zero4() { unsigned z; asm volatile("v_mov_b32 %0, 0" : "=v"(z)); return (u32x4){z, z, z, z}; }
__device__ __forceinline__ float bf2f(bf16_t v) { return __uint_as_float(((unsigned)v) << 16); }

__device__ __forceinline__ unsigned pack2(float lo, float hi) { unsigned r; asm("v_cvt_pk_bf16_f32 %0, %1, %2" : "=v"(r) : "v"(lo), "v"(hi)); return r; }
__device__ __forceinline__ bf16_t f2bf(float f) { return (bf16_t)(pack2(f, f) & 0xffffu); }
__device__ __forceinline__ float lo16(unsigned w) { return __uint_as_float(w << 16); }
__device__ __forceinline__ float hi16(unsigned w) { return __uint_as_float(w & 0xffff0000u); }
__device__ __forceinline__ float gelu_as(float v) {
    const float av = fabsf(v), t = __builtin_amdgcn_rcpf(av * 0.2316418882f + 1.0f);
    float q = t * 0.5307027145f + (-0.7265760135f); q = q * t + 0.7107068705f; q = q * t + (-0.142248368f); q = q * t + 0.127414796f; q = q * t;
    const float e = __builtin_amdgcn_exp2f(v * v * (-0.72134752044f)); const float m = v * (q * e);
    return v < 0.f ? m : v - m;
}
__device__ __forceinline__ float sigm(float x) { return __builtin_amdgcn_rcpf(1.0f + __expf(-x)); }

namespace pg8 {
constexpr int BM = 256, BK = 64, HALF = 128, HTB = HALF * BK * 2, STAGE_BYTES = 8 * HTB, NXCD = 8, WGM = 8;
__device__ __forceinline__ int lds_byte(int r, int c) { const int st = (r >> 4) * 2 + (c >> 5), rr = r & 15, cc = c & 31, ob = rr * 64 + cc * 2; return st * 1024 + (ob ^ (((ob >> 9) & 1) << 5)); }
__device__ __forceinline__ void stage_rc(int b, int& R, int& C) { const int st = b / 1024, sb = b % 1024, swz = sb ^ (((sb >> 9) & 1) << 5); R = (st >> 1) * 16 + swz / 64; C = (st & 1) * 32 + (swz % 64) / 2; }
__device__ __forceinline__ int perm32(int rho) { const int n = rho >> 4, i = rho & 15; return 8 * (i >> 2) + 4 * n + (i & 3); }
struct Unit { int pm, pn; };
struct Gemm { const bf16_t* A; const bf16_t* Bt; };
struct StaticOrder {
    int nM, nN, nwg, G, c;
    __device__ void init(int M, int N, int G_, int c_) { nM = M / BM; nN = N / BM; nwg = nM * nN; G = G_; c = c_; }
    __device__ bool next(int i, Unit& u) const {
        const long L = (long)i * G + c; if (L >= nwg) return false;
        int wgid = (int)L; { const int q = nwg / NXCD, r = nwg % NXCD, xcd = wgid % NXCD, off = wgid / NXCD; wgid = (xcd < r ? xcd * (q + 1) : r * (q + 1) + (xcd - r) * q) + off; }
        const int nig = WGM * nN, gid = wgid / nig, fm = gid * WGM, gsz = (nM - fm) < WGM ? (nM - fm) : WGM;
        u.pm = fm + ((wgid % nig) % gsz); u.pn = (wgid % nig) / gsz; return true;
    }
};
template <class Epi, int LDA, int LDB, int KK>
__device__ __forceinline__ void gemm_phase(int wv, LAS unsigned char* lds, const Gemm g, const StaticOrder& S, const Epi& E) {
    const int tid = opaque_tid(wv), wid = __builtin_amdgcn_readfirstlane(tid >> 6), lane = tid & 63, wr = wid >> 2, wc = wid & 3, fr = lane & 15, fq = lane >> 4;
    constexpr int nt = KK / BK;
    unsigned voffA[2], voffB[2];
#pragma unroll
    for (int i = 0; i < 2; ++i) { int R, C; stage_rc(tid * 16 + i * 8192, R, C); const int Rb = (R & ~31) + perm32(R & 31);
        voffA[i] = (unsigned)(R * LDA + C) * 2u; voffB[i] = (unsigned)(Rb * LDB + C) * 2u; }
    constexpr size_t kstep = (size_t)(BK * 2);
    constexpr size_t hstepA = (size_t)HALF * LDA * 2, hstepB = (size_t)HALF * LDB * 2;
    constexpr size_t tstepA = 2 * hstepA, tstepB = 2 * hstepB;
    const unsigned ldsw = (unsigned)wid * 1024u;
    const int aoff = lds_byte(wr * 64 + fr, fq * 8), boff = lds_byte(wc * 32 + fr, fq * 8);
#define PG8_SA(b, h) (((b) * 2 + (h)) * HTB)
#define PG8_SB(b, h) ((4 + (b) * 2 + (h)) * HTB)
#define PG8_STAGE(bufoff, gbase, voff) do { _Pragma("unroll") for (int _i = 0; _i < 2; ++_i) \
        __builtin_amdgcn_global_load_lds((const unsigned*)((const char*)(gbase) + (voff)[_i]), (LAS unsigned*)(lds + (bufoff) + ldsw + _i * 8192), 16, 0, 0); } while (0)
#define PG8_LDA(dst, b, h) do { _Pragma("unroll") for (int m = 0; m < 4; ++m) _Pragma("unroll") for (int k = 0; k < 2; ++k) dst[m][k] = *(const LAS bf16x8*)(lds + PG8_SA(b, h) + aoff + m * 2048 + k * 1024); } while (0)
#define PG8_LDB(dst, b, h) do { _Pragma("unroll") for (int n = 0; n < 2; ++n) _Pragma("unroll") for (int k = 0; k < 2; ++k) dst[n][k] = *(const LAS bf16x8*)(lds + PG8_SB(b, h) + boff + n * 2048 + k * 1024); } while (0)
#define PG8_MMA(ai, bj, At, Bt) do { __builtin_amdgcn_s_setprio(1); _Pragma("unroll") for (int m = 0; m < 4; ++m) _Pragma("unroll") for (int n = 0; n < 2; ++n) _Pragma("unroll") for (int k = 0; k < 2; ++k) \
        acc[ai][bj][m][n] = __builtin_amdgcn_mfma_f32_16x16x32_bf16(Bt[n][k], At[m][k], acc[ai][bj][m][n], 0, 0, 0); __builtin_amdgcn_s_setprio(0); } while (0)
#define PG8_WAIT_V(n) asm volatile("s_waitcnt vmcnt(" #n ")" ::: "memory")
#define PG8_WAIT_L(n) asm volatile("s_waitcnt lgkmcnt(" #n ")" ::: "memory")
#define PG8_BAR __builtin_amdgcn_s_barrier()
#define PG8_SCHED __builtin_amdgcn_sched_barrier(0)
    Unit cur, nxt; int ui = 0;
    if (!S.next(0, cur)) return;
    f32x4 acc[2][2][4][2];
#pragma unroll
    for (int a = 0; a < 2; ++a)
#pragma unroll
        for (int b = 0; b < 2; ++b)
#pragma unroll
            for (int m = 0; m < 4; ++m)
#pragma unroll
                for (int n = 0; n < 2; ++n) acc[a][b][m][n] = (f32x4){0.f, 0.f, 0.f, 0.f};
    bf16x8 At[4][2], B0[2][2], B1[2][2];
    const char* cA = (const char*)g.A + (size_t)cur.pm * tstepA; const char* cB = (const char*)g.Bt + (size_t)cur.pn * tstepB;
    if constexpr (Epi::ROWSCALE) { if (wid < 4) __builtin_amdgcn_global_load_lds((const unsigned*)(E.rsq + cur.pm * 256 + wid * 64 + lane), (LAS unsigned*)(lds + 131072 + wid * 256), 4, 0, 0); }
    PG8_STAGE(PG8_SB(0, 0), cB, voffB); PG8_STAGE(PG8_SA(0, 0), cA, voffA); PG8_STAGE(PG8_SB(0, 1), cB + hstepB, voffB); PG8_STAGE(PG8_SA(0, 1), cA + hstepA, voffA);
    if (wr == 1) PG8_BAR;
    PG8_WAIT_V(4); PG8_BAR;
    PG8_STAGE(PG8_SB(1, 0), cB + kstep, voffB); PG8_STAGE(PG8_SA(1, 0), cA + kstep, voffA); PG8_STAGE(PG8_SB(1, 1), cB + hstepB + kstep, voffB);
    PG8_WAIT_V(6); PG8_BAR;
    for (;;) {
        const bool has_next = S.next(ui + 1, nxt);
        const char* nA = has_next ? (const char*)g.A + (size_t)nxt.pm * tstepA : cA; const char* nB = has_next ? (const char*)g.Bt + (size_t)nxt.pn * tstepB : cB;
        if constexpr (Epi::ROWSCALE) { if (has_next && wid < 4) __builtin_amdgcn_global_load_lds((const unsigned*)(E.rsq + nxt.pm * 256 + wid * 64 + lane), (LAS unsigned*)(lds + 131072 + ((ui + 1) % 3) * 1024 + wid * 256), 4, 0, 0); }
        for (int seg = 0, t = 0; seg < Epi::NSEG; ++seg) {
          const int tend = Epi::HAS_MID ? (seg == 0 ? Epi::MID1 : (seg == 1 ? Epi::MID2 : nt)) : nt;
          for (; t < tend; t += 2) {
            const bool last = (t == nt - 2);
            const char* a1 = cA + (size_t)(t + 1) * kstep;
            const char* a2 = last ? nA : cA + (size_t)(t + 2) * kstep; const char* b2 = last ? nB : cB + (size_t)(t + 2) * kstep;
            const char* a3 = a2 + kstep; const char* b3 = b2 + kstep;
            PG8_LDB(B0, 0, 0); PG8_SCHED; PG8_LDA(At, 0, 0); PG8_STAGE(PG8_SA(1, 1), a1 + hstepA, voffA);
            PG8_WAIT_L(8); PG8_BAR; PG8_WAIT_L(0); PG8_MMA(0, 0, At, B0); PG8_BAR; PG8_SCHED;
            PG8_LDB(B1, 0, 1); PG8_STAGE(PG8_SB(0, 0), b2, voffB);
            PG8_BAR; PG8_WAIT_L(0); PG8_MMA(0, 1, At, B1); PG8_BAR;
            PG8_LDA(At, 0, 1); PG8_STAGE(PG8_SA(0, 0), a2, voffA);
            PG8_BAR; PG8_WAIT_L(0); PG8_MMA(1, 0, At, B0); PG8_BAR; PG8_SCHED;
            PG8_STAGE(PG8_SB(0, 1), b2 + hstepB, voffB);
            PG8_WAIT_V(6); PG8_BAR; PG8_MMA(1, 1, At, B1); PG8_BAR;
            PG8_LDB(B0, 1, 0); PG8_SCHED; PG8_LDA(At, 1, 0); PG8_STAGE(PG8_SA(0, 1), a2 + hstepA, voffA);
            PG8_WAIT_L(8); PG8_BAR; PG8_WAIT_L(0); PG8_MMA(0, 0, At, B0); PG8_BAR; PG8_SCHED;
            PG8_LDB(B1, 1, 1); PG8_STAGE(PG8_SB(1, 0), b3, voffB);
            PG8_BAR; PG8_WAIT_L(0); PG8_MMA(0, 1, At, B1); PG8_BAR;
            PG8_LDA(At, 1, 1); PG8_STAGE(PG8_SA(1, 0), a3, voffA);
            PG8_BAR; PG8_WAIT_L(0); PG8_MMA(1, 0, At, B0); PG8_BAR; PG8_SCHED;
            PG8_STAGE(PG8_SB(1, 1), b3 + hstepB, voffB);
            PG8_WAIT_V(6); PG8_BAR; PG8_MMA(1, 1, At, B1); PG8_BAR;
          }
          if constexpr (Epi::HAS_MID) { if (seg < Epi::NSEG - 1) E.mid(acc, cur, seg, wr, wc, fr, fq); }
        }
        E(acc, cur, wr, wc, fr, fq, (const LAS float*)(lds + 131072 + (ui % 3) * 1024));
        if (!has_next) break;
#pragma unroll
        for (int a = 0; a < 2; ++a)
#pragma unroll
            for (int b = 0; b < 2; ++b)
#pragma unroll
                for (int m = 0; m < 4; ++m)
#pragma unroll
                    for (int n = 0; n < 2; ++n) acc[a][b][m][n] = (f32x4){0.f, 0.f, 0.f, 0.f};
        cur = nxt; cA = nA; cB = nB; ++ui;
    }
    PG8_WAIT_V(0);
    if (wr == 0) PG8_BAR;
    PG8_BAR;
#undef PG8_SA
#undef PG8_SB
#undef PG8_STAGE
#undef PG8_LDA
#undef PG8_LDB
#undef PG8_MMA
#undef PG8_WAIT_V
#undef PG8_WAIT_L
#undef PG8_BAR
#undef PG8_SCHED
}
}

typedef f32x4 AccT[2][2][4][2];

__device__ __forceinline__ u32x4 pack8(const f32x4& a, const f32x4& b) { u32x4 w; w.x = pack2(a[0], a[1]); w.y = pack2(a[2], a[3]); w.z = pack2(b[0], b[1]); w.w = pack2(b[2], b[3]); return w; }

struct EpiZ {
    static constexpr bool HAS_MID = false, ROWSCALE = true; static constexpr int MID1 = -1, MID2 = -1, NSEG = 1;
    bf16_t* zA; bf16_t* zG; float* gates; const float* rsq;
    __device__ __forceinline__ void mid(AccT&, const pg8::Unit&, int, int, int, int, int) const {}
    __device__ __forceinline__ void operator()(AccT& acc, const pg8::Unit& u, int wr, int wc, int fr, int fq, const LAS float* rs) const {
        int row0 = u.pm * 256 + wr * 64 + fr; asm volatile("" : "+v"(row0)); const int cb = wc * 32 + 8 * fq;
        if (u.pn < 52) {
            bf16_t* base = u.pn < 28 ? zA + u.pn * 256 : zG + (u.pn - 28) * 256; const int ld = u.pn < 28 ? NZA : NZG;
#pragma unroll
            for (int ai = 0; ai < 2; ++ai)
#pragma unroll
                for (int m = 0; m < 4; ++m) {
                    const int row = row0 + ai * 128 + m * 16; const float sc = rsqrtf(rs[ai * 128 + wr * 64 + m * 16 + fr] * (1.0f / D) + EPS);
#pragma unroll
                    for (int bj = 0; bj < 2; ++bj) {
                        f32x4 v0 = acc[ai][bj][m][0] * sc, v1 = acc[ai][bj][m][1] * sc;
                        if (u.pn >= 28) {
#pragma unroll
                            for (int i = 0; i < 4; ++i) { v0[i] = __expf(-v0[i]); v1[i] = __expf(-v1[i]); } }
                        *(u32x4*)(base + (size_t)row * ld + bj * 128 + cb) = pack8(v0, v1);
                    }
                }
        } else if (wc == 0 && fq == 0) {
#pragma unroll
            for (int ai = 0; ai < 2; ++ai)
#pragma unroll
                for (int m = 0; m < 4; ++m) {
                    const int row = row0 + ai * 128 + m * 16; const float sc = rsqrtf(rs[ai * 128 + wr * 64 + m * 16 + fr] * (1.0f / D) + EPS);
                    *(f32x4*)(gates + (size_t)row * 8) = acc[ai][0][m][0] * sc; *(f32x4*)(gates + (size_t)row * 8 + 4) = acc[ai][0][m][1] * sc;
                }
        }
    }
};
struct EpiMerge {
    static constexpr bool HAS_MID = true, ROWSCALE = false; static constexpr int MID1 = 8, MID2 = 24, NSEG = 3;
    const bf16_t* zG; bf16_t* mb;
    __device__ __forceinline__ void mid(AccT& acc, const pg8::Unit& u, int which, int wr, int wc, int fr, int fq) const {
        int row0 = u.pm * 256 + wr * 64 + fr; asm volatile("" : "+v"(row0)); const int cb = u.pn * 256 + wc * 32 + 8 * fq; const int onum = which * 2048, oden = onum + 2048;
#pragma unroll
        for (int ai = 0; ai < 2; ++ai) {
            u32x4 gn[4][2], gd[4][2];
#pragma unroll
            for (int m = 0; m < 4; ++m)
#pragma unroll
                for (int bj = 0; bj < 2; ++bj) { const bf16_t* zr = zG + (size_t)(row0 + ai * 128 + m * 16) * NZG + cb + bj * 128; gn[m][bj] = *(const u32x4*)(zr + onum); gd[m][bj] = *(const u32x4*)(zr + oden); }
#pragma unroll
            for (int m = 0; m < 4; ++m)
#pragma unroll
                for (int bj = 0; bj < 2; ++bj)
#pragma unroll
                    for (int q = 0; q < 4; ++q) {
                        const float r0 = (1.0f + lo16(gd[m][bj][q])) * __builtin_amdgcn_rcpf(1.0f + lo16(gn[m][bj][q])), r1 = (1.0f + hi16(gd[m][bj][q])) * __builtin_amdgcn_rcpf(1.0f + hi16(gn[m][bj][q]));
                        acc[ai][bj][m][q >> 1][(q & 1) * 2] *= r0; acc[ai][bj][m][q >> 1][(q & 1) * 2 + 1] *= r1;
                    }
        }
    }
    __device__ __forceinline__ void operator()(AccT& acc, const pg8::Unit& u, int wr, int wc, int fr, int fq, const LAS float* rs) const {
        int row0 = u.pm * 256 + wr * 64 + fr; asm volatile("" : "+v"(row0)); const int cb = u.pn * 256 + wc * 32 + 8 * fq;
#pragma unroll
        for (int ai = 0; ai < 2; ++ai) {
            u32x4 gd[4][2];
#pragma unroll
            for (int m = 0; m < 4; ++m)
#pragma unroll
                for (int bj = 0; bj < 2; ++bj) gd[m][bj] = *(const u32x4*)(zG + (size_t)(row0 + ai * 128 + m * 16) * NZG + 4096 + cb + bj * 128);
#pragma unroll
            for (int m = 0; m < 4; ++m)
#pragma unroll
                for (int bj = 0; bj < 2; ++bj) {
                    const int row = row0 + ai * 128 + m * 16, col = cb + bj * 128; const u32x4 g = gd[m][bj];
                    f32x4 v0 = acc[ai][bj][m][0], v1 = acc[ai][bj][m][1];
                    v0[0] *= __builtin_amdgcn_rcpf(1.0f + lo16(g[0])); v0[1] *= __builtin_amdgcn_rcpf(1.0f + hi16(g[0])); v0[2] *= __builtin_amdgcn_rcpf(1.0f + lo16(g[1])); v0[3] *= __builtin_amdgcn_rcpf(1.0f + hi16(g[1]));
                    v1[0] *= __builtin_amdgcn_rcpf(1.0f + lo16(g[2])); v1[1] *= __builtin_amdgcn_rcpf(1.0f + hi16(g[2])); v1[2] *= __builtin_amdgcn_rcpf(1.0f + lo16(g[3])); v1[3] *= __builtin_amdgcn_rcpf(1.0f + hi16(g[3]));
                    *(u32x4*)(mb + (size_t)row * D + col) = pack8(v0, v1);
                }
        }
    }
};
struct EpiResid {
    static constexpr bool HAS_MID = false, ROWSCALE = false; static constexpr int MID1 = -1, MID2 = -1, NSEG = 1;
    float* h; bf16_t* hb; float* rsqn;
    __device__ __forceinline__ void mid(AccT&, const pg8::Unit&, int, int, int, int, int) const {}
    __device__ __forceinline__ void operator()(AccT& acc, const pg8::Unit& u, int wr, int wc, int fr, int fq, const LAS float* rs) const {
        int row0 = u.pm * 256 + wr * 64 + fr; asm volatile("" : "+v"(row0)); const int cb = u.pn * 256 + wc * 32 + 8 * fq, lane = fr + 16 * fq;
#pragma unroll
        for (int ai = 0; ai < 2; ++ai) {
            f32x4 hv[4][2][2];
#pragma unroll
            for (int m = 0; m < 4; ++m)
#pragma unroll
                for (int bj = 0; bj < 2; ++bj) { const float* hp = h + (size_t)(row0 + ai * 128 + m * 16) * D + cb + bj * 128; hv[m][bj][0] = *(const f32x4*)hp; hv[m][bj][1] = *(const f32x4*)(hp + 4); }
#pragma unroll
            for (int m = 0; m < 4; ++m) {
                const int row = row0 + ai * 128 + m * 16; float ss = 0.f;
#pragma unroll
                for (int bj = 0; bj < 2; ++bj) {
                    const int col = cb + bj * 128; float* hp = h + (size_t)row * D + col;
                    const f32x4 o0 = hv[m][bj][0] + acc[ai][bj][m][0], o1 = hv[m][bj][1] + acc[ai][bj][m][1];
                    *(f32x4*)hp = o0; *(f32x4*)(hp + 4) = o1;
                    *(u32x4*)(hb + (size_t)row * D + col) = pack8(o0, o1);
                    ss += o0[0] * o0[0] + o0[1] * o0[1] + o0[2] * o0[2] + o0[3] * o0[3] + o1[0] * o1[0] + o1[1] * o1[1] + o1[2] * o1[2] + o1[3] * o1[3];
                }
                ss += shx(ss, 16, lane); ss += shx(ss, 32, lane);
                if (fq == 0) atomicAdd(rsqn + row, ss);
            }
        }
    }
};
struct EpiUp {
    static constexpr bool HAS_MID = false, ROWSCALE = true; static constexpr int MID1 = -1, MID2 = -1, NSEG = 1;
    bf16_t* z2; const float* rsq;
    __device__ __forceinline__ void mid(AccT&, const pg8::Unit&, int, int, int, int, int) const {}
    __device__ __forceinline__ void operator()(AccT& acc, const pg8::Unit& u, int wr, int wc, int fr, int fq, const LAS float* rs) const {
        int row0 = u.pm * 256 + wr * 64 + fr; asm volatile("" : "+v"(row0)); const int cb = u.pn * 256 + wc * 32 + 8 * fq;
#pragma unroll
        for (int ai = 0; ai < 2; ++ai)
#pragma unroll
            for (int m = 0; m < 4; ++m) {
                const int row = row0 + ai * 128 + m * 16; const float sc = rsqrtf(rs[ai * 128 + wr * 64 + m * 16 + fr] * (1.0f / D) + EPS);
#pragma unroll
                for (int bj = 0; bj < 2; ++bj) *(u32x4*)(z2 + (size_t)row * NUP + cb + bj * 128) = pack8(acc[ai][bj][m][0] * sc, acc[ai][bj][m][1] * sc);
            }
    }
};

template <int LDA, int LDB, int M, int N, int K, class Epi>
__device__ __forceinline__ void run_gemm(int wv, LAS unsigned char* lds, const bf16_t* A, const bf16_t* Bt, const Epi& E) {
    pg8::Gemm g; g.A = A; g.Bt = Bt;
    pg8::StaticOrder S; S.init(M, N, (int)gridDim.x, opaque_bid());
    pg8::gemm_phase<Epi, LDA, LDB, K>(wv, lds, g, S, E);
}

__device__ __forceinline__ void convert_weight(int wv, const float* __restrict__ src, int ldsrc, int Ksrc, bf16_t* dst, int ldd, int koff, int ntn, const float* kscale, int mode, LAS float* tile, int pidx, int pcnt) {
    const int tid = opaque_tid(wv); const int ntk = Ksrc / 128; const int total = ntn * ntk; const int G = pcnt;
    const int kk0 = tid >> 4, n4 = (tid & 15) * 4;
    f32x4 v[4]; float ks[4];
    auto prefetch = [&](int t) {
        const int tn = t % ntn, tk = t / ntn; const int n0 = tn * 64, k0 = tk * 128;
        int scol = n0, nvalid = 64;
        if (mode == 1) { if (n0 < 5632) scol = n0; else if (n0 < 13312) scol = n0 + 8; else if (n0 == 13312) { scol = 5632; nvalid = 8; } else { scol = 0; nvalid = 0; } }
#pragma unroll
        for (int i = 0; i < 4; ++i) { const int kk = kk0 + i * 32; v[i] = (f32x4){0.f, 0.f, 0.f, 0.f};
            if (n4 < nvalid) v[i] = *(const f32x4*)(src + (size_t)(k0 + kk) * ldsrc + scol + n4);
            ks[i] = kscale ? kscale[k0 + kk] : 1.0f; }
    };
    int t = pidx; int buf = 0;
    if (t < total) prefetch(t);
    for (; t < total; t += G) {
        LAS float* tl = tile + buf * (128 * 65);
#pragma unroll
        for (int i = 0; i < 4; ++i) { const int kk = kk0 + i * 32;
            tl[kk * 65 + n4 + 0] = v[i][0] * ks[i]; tl[kk * 65 + n4 + 1] = v[i][1] * ks[i]; tl[kk * 65 + n4 + 2] = v[i][2] * ks[i]; tl[kk * 65 + n4 + 3] = v[i][3] * ks[i]; }
        lds_barrier();
        const int tn = t % ntn, tk = t / ntn; const int n0 = tn * 64, k0 = tk * 128;
        if (t + G < total) prefetch(t + G);
        { const int n = tid >> 3, k16 = (tid & 7) * 16; u32x4 w0, w1;
          w0.x = pack2(tl[(k16 + 0) * 65 + n], tl[(k16 + 1) * 65 + n]); w0.y = pack2(tl[(k16 + 2) * 65 + n], tl[(k16 + 3) * 65 + n]);
          w0.z = pack2(tl[(k16 + 4) * 65 + n], tl[(k16 + 5) * 65 + n]); w0.w = pack2(tl[(k16 + 6) * 65 + n], tl[(k16 + 7) * 65 + n]);
          w1.x = pack2(tl[(k16 + 8) * 65 + n], tl[(k16 + 9) * 65 + n]); w1.y = pack2(tl[(k16 + 10) * 65 + n], tl[(k16 + 11) * 65 + n]);
          w1.z = pack2(tl[(k16 + 12) * 65 + n], tl[(k16 + 13) * 65 + n]); w1.w = pack2(tl[(k16 + 14) * 65 + n], tl[(k16 + 15) * 65 + n]);
          bf16_t* dp = dst + (size_t)(n0 + n) * ldd + koff + k0 + k16; *(u32x4*)dp = w0; *(u32x4*)(dp + 8) = w1; }
        buf ^= 1;
    }
    __syncthreads();
}
__device__ __forceinline__ void convert_layer(int wv, PP P, int L, int mask, LAS float* tile, int pidx, int pcnt) {
    unsigned char* ws = P->ws; unsigned char* dob = (unsigned char*)P->out;
    if (mask & 1) convert_weight(wv, P->w_in + (size_t)L * D * DIN, DIN, D, (bf16_t*)(ws + WS_WIN), D, 0, NZ / 64, P->norm_mix + L * D, 1, tile, pidx, pcnt);
    if (mask & 2) {
        bf16_t* wbr = (bf16_t*)(dob + DO_WBR);
        convert_weight(wv, P->w_br_a + (size_t)L * 512 * D, D, 512, wbr, D, 0, D / 64, nullptr, 0, tile, pidx, pcnt);
        convert_weight(wv, P->w_br_m + (size_t)L * 1024 * D, D, 1024, wbr, D, 512, D / 64, nullptr, 0, tile, pidx, pcnt);
        convert_weight(wv, P->w_br_d + (size_t)L * 512 * D, D, 512, wbr, D, 1536, D / 64, nullptr, 0, tile, pidx, pcnt);
    }
    if (mask & 4) convert_weight(wv, P->w_out + (size_t)L * D * D, D, D, (bf16_t*)(dob + DO_WOUT), D, 0, D / 64, nullptr, 0, tile, pidx, pcnt);
    if (mask & 8) convert_weight(wv, P->w_up + (size_t)L * D * NUP, NUP, D, (bf16_t*)(dob + DO_WUP), D, 0, NUP / 64, P->norm_ffn + L * D, 0, tile, pidx, pcnt);
    if (mask & 16) convert_weight(wv, P->w_down + (size_t)L * DFF * D, D, DFF, (bf16_t*)(ws + WS_WDOWN), DFF, 0, D / 64, nullptr, 0, tile, pidx, pcnt);
}

__device__ __forceinline__ void init_phase(int wv, PP P) {
    float* hp = (float*)(P->ws + WS_HP); bf16_t* hb = (bf16_t*)((unsigned char*)P->out + DO_HB); float* rsq = (float*)(P->ws + WS_RSQ); float* hsq = (float*)(P->ws + WS_HSQ);
    const int tid = opaque_tid(wv), w = tid >> 6, lane = tid & 63;
    for (int row = blockIdx.x * 8 + w; row < MP; row += gridDim.x * 8) {
        const int b = row / LP, pp = row % LP;
        const float* src = pp < PADN ? nullptr : (pp < LEADR ? P->meta + (size_t)(pp - PADN) * D : P->x + ((size_t)b * SEQ + (pp - LEADR)) * D);
        float ss = 0.f;
#pragma unroll
        for (int i = 0; i < 8; ++i) {
            const int c = (i * 64 + lane) * 4; f32x4 v = (f32x4){0.f, 0.f, 0.f, 0.f}; if (src) v = *(const f32x4*)(src + c);
            *(f32x4*)(hp + (size_t)row * D + c) = v; u32x2 o; o.x = pack2(v[0], v[1]); o.y = pack2(v[2], v[3]); *(u32x2*)(hb + (size_t)row * D + c) = o;
            ss += v[0] * v[0] + v[1] * v[1] + v[2] * v[2] + v[3] * v[3];
        }
#pragma unroll
        for (int o = 1; o < 64; o <<= 1) ss += shx(ss, o, lane);
        if (lane == 0) rsq[row] = ss;
    }
    for (int i = blockIdx.x * 512 + tid; i < 4 * MP; i += gridDim.x * 512) rsq[MP + i] = 0.f;
    for (int i = blockIdx.x * 512 + tid; i < 8 * MP; i += gridDim.x * 512) hsq[i] = 0.f;
}

__device__ __forceinline__ void conva_phase(int wv, PP P, int L) {
    const bf16_t* zA = (const bf16_t*)(P->ws + WS_Z); bf16_t* cat = (bf16_t*)((unsigned char*)P->out + DO_HB); const float* cw = P->conv_a + (size_t)L * 3 * 512;
    const int total = MP * 64;
    for (int idx = opaque_bid() * 512 + opaque_tid(wv); idx < total; idx += gridDim.x * 512) {
        const int row = idx >> 6, c = (idx & 63) * 8; const int pp = row % LP; u32x4 o = zero4();
        if (pp >= PADN) {
            float y[8];
#pragma unroll
            for (int i = 0; i < 8; ++i) y[i] = 0.f;
#pragma unroll
            for (int j = 0; j < 3; ++j) {
                const bf16_t* zr = zA + (size_t)(row - 2 + j) * NZA; const u32x4 ax = *(const u32x4*)(zr + ZA_AX + c), ac = *(const u32x4*)(zr + ZA_AC + c);
                const f32x4 w0 = *(const f32x4*)(cw + j * 512 + c), w1 = *(const f32x4*)(cw + j * 512 + c + 4);
#pragma unroll
                for (int q = 0; q < 4; ++q) { const float wa = q < 2 ? w0[q * 2] : w1[(q - 2) * 2], wb = q < 2 ? w0[q * 2 + 1] : w1[(q - 2) * 2 + 1];
                    y[2 * q] += wa * lo16(ax[q]) * lo16(ac[q]); y[2 * q + 1] += wb * hi16(ax[q]) * hi16(ac[q]); }
            }
            const u32x4 ab = *(const u32x4*)(zA + (size_t)row * NZA + ZA_AB + c);
#pragma unroll
            for (int q = 0; q < 4; ++q) o[q] = pack2(y[2 * q] * lo16(ab[q]), y[2 * q + 1] * hi16(ab[q]));
        }
        *(u32x4*)(cat + (size_t)row * D + c) = o;
    }
}

constexpr int ML_QS = 0, ML_KS = 33792, ML_CB = 67584, ML_VS = 92928, ML_VW = 98048, ML_PB = 105216, ML_SC = 114432;
__device__ __forceinline__ void mlstm_phase(int wv, PP P, int L, LAS unsigned char* lds) {
    const int tid = opaque_tid(wv), w = __builtin_amdgcn_readfirstlane(tid >> 6), lane = tid & 63, fr = lane & 15, fq = lane >> 4;
    const bf16_t* zA = (const bf16_t*)(P->ws + WS_Z); const float* gates = (const float*)(P->ws + WS_GATES);
    bf16_t* cat = (bf16_t*)((unsigned char*)P->out + DO_HB); float* hsq = (float*)(P->ws + WS_HSQ) + (size_t)L * MP * 4;
    LAS float* sc_a = (LAS float*)(lds + ML_SC); LAS float* sc_M = sc_a + 64; LAS float* sc_b = sc_a + 128; LAS float* sc_wk = sc_a + 192; LAS float* sc_rs = sc_a + 256; LAS float* sc_nq = sc_a + 384;
    LAS bf16_t* PB = (LAS bf16_t*)(lds + ML_PB); LAS bf16_t* CB = (LAS bf16_t*)(lds + ML_CB);
    const int mt = w >> 1, ntp = (w & 1) * 2, et = w & 1;
    const int trq = (lane >> 2) & 3, trp = lane & 3;
    const unsigned ldsb = (unsigned)(size_t)lds;
    const unsigned tr_k = ldsb + ML_KS + (8 * fq + trq) * 528 + (2 * w * 16 + 4 * trp) * 2;
    const unsigned tr_vw = ldsb + ML_VW + (8 * fq + trq) * 112 + (4 * trp) * 2;
    const unsigned tr_vs = ldsb + ML_VS + (8 * fq + trq) * 80 + (et * 16 + 4 * trp) * 2;
    f32x4* gsc = (f32x4*)(P->ws + WS_GSC) + (size_t)opaque_bid() * 34 * 64;
    for (int item = opaque_bid(); item < 256; item += gridDim.x) {
        const int b = item >> 5, h = (item >> 3) & 3, e0 = (item & 7) * 32;
        const float bi = P->b_if[L * 8 + h], bfg = P->b_if[L * 8 + 4 + h];
        __syncthreads();
        for (int i = tid; i < (25344 + 5120 + 7168) / 4; i += 512) ((LAS unsigned*)(lds + ML_CB))[i] = 0u;
        for (int c = w; c < 33; c += 8) {
            const size_t rr = (size_t)b * LP + (size_t)c * 64; const int t = lane; const bool valid = (c * 64 + t) >= PADN;
            const float gi = gates[(rr + t) * 8 + h] + bi, gf = gates[(rr + t) * 8 + 4 + h] + bfg;
            const float li = valid ? gi : -INFINITY;
            const float lf = valid ? (fminf(gf, 0.f) - log1pf(__expf(-fabsf(gf)))) : 0.f;
            float bc = lf;
#pragma unroll
            for (int o = 1; o < 64; o <<= 1) { const float y = shup(bc, o, lane); if (lane >= o) bc += y; }
            const float a = li - bc; float mx = a;
#pragma unroll
            for (int o = 1; o < 64; o <<= 1) { const float y = shup(mx, o, lane); if (lane >= o) mx = fmaxf(mx, y); }
            gsc[c * 64 + t] = (f32x4){bc, a, mx, 0.f};
        }
        f32x4 Cacc[3][2];
#pragma unroll
        for (int a = 0; a < 3; ++a)
#pragma unroll
            for (int c = 0; c < 2; ++c) Cacc[a][c] = (f32x4){0.f, 0.f, 0.f, 0.f};
        float m_prev = 0.f;
        u32x4 qreg[4], kreg[4], vreg; f32x4 greg = (f32x4){0.f, 0.f, 0.f, 0.f};
        auto fetch = [&](int cc) {
            const size_t rr = (size_t)b * LP + (size_t)cc * 64;
#pragma unroll
            for (int i = 0; i < 4; ++i) { const int id = tid + i * 512, t = id >> 5, d8 = (id & 31) * 8;
                qreg[i] = *(const u32x4*)(zA + (rr + t) * NZA + ZA_MQ + h * 256 + d8); kreg[i] = *(const u32x4*)(zA + (rr + t) * NZA + ZA_MK + h * 256 + d8); }
            if (tid < 256) { const int s = tid >> 2, e8 = (tid & 3) * 8; vreg = *(const u32x4*)(zA + (rr + s) * NZA + ZA_MV + h * 256 + e0 + e8); }
            if (w == 7) greg = gsc[cc * 64 + lane];
        };
        __syncthreads();
        fetch(0);
        for (int c = 0; c < 33; ++c) {
            const size_t r0 = (size_t)b * LP + (size_t)c * 64;
#pragma unroll
            for (int i = 0; i < 4; ++i) { const int id = tid + i * 512, t = id >> 5, d8 = (id & 31) * 8;
                *(LAS u32x4*)(lds + ML_QS + t * 528 + d8 * 2) = qreg[i]; *(LAS u32x4*)(lds + ML_KS + t * 528 + d8 * 2) = kreg[i]; }
            if (tid < 256) { const int s = tid >> 2, e8 = (tid & 3) * 8; *(LAS u32x4*)(lds + ML_VS + s * 80 + e8 * 2) = vreg; }
            if (w == 7) {
                const int t = lane; const float bc = greg[0], a = greg[1]; const float Mt = fmaxf(greg[2], m_prev); const float M63 = shidx(Mt, 63);
                sc_a[t] = a; sc_M[t] = Mt; sc_b[t] = bc; sc_wk[t] = __expf(a - M63) * 0.0625f; sc_nq[64 + t] = greg[3];
            }
            lds_barrier();
            if (c + 1 < 33) fetch(c + 1);
            const float M63 = sc_M[63], b63 = sc_b[63]; const float gs = __expf(m_prev - M63), m_new = b63 + M63;
            { const int sr = tid >> 3, e4 = (tid & 7) * 4; const u32x2 v = *(const LAS u32x2*)(lds + ML_VS + sr * 80 + e4 * 2); const float wk = sc_wk[sr];
              u32x2 o; o.x = pack2(lo16(v.x) * wk, hi16(v.x) * wk); o.y = pack2(lo16(v.y) * wk, hi16(v.y) * wk); *(LAS u32x2*)(lds + ML_VW + sr * 112 + e4 * 2) = o;
              if ((tid & 7) == 0) *(LAS bf16_t*)(lds + ML_VW + sr * 112 + 64) = f2bf(wk); }
            bf16x8 aq[8];
#pragma unroll
            for (int kk = 0; kk < 8; ++kk) aq[kk] = *(const LAS bf16x8*)(lds + ML_QS + (mt * 16 + fr) * 528 + (kk * 32 + fq * 8) * 2);
            f32x4 s0 = (f32x4){0.f, 0.f, 0.f, 0.f}, s1 = s0, ov = s0, ovn = s0;
#pragma unroll
            for (int kk = 0; kk < 8; ++kk) {
                const bf16x8 b0 = *(const LAS bf16x8*)(lds + ML_KS + (ntp * 16 + fr) * 528 + (kk * 32 + fq * 8) * 2);
                const bf16x8 b1 = *(const LAS bf16x8*)(lds + ML_KS + ((ntp + 1) * 16 + fr) * 528 + (kk * 32 + fq * 8) * 2);
                const bf16x8 bq = *(const LAS bf16x8*)(lds + ML_CB + (et * 16 + fr) * 528 + (kk * 32 + fq * 8) * 2);
                s0 = __builtin_amdgcn_mfma_f32_16x16x32_bf16(aq[kk], b0, s0, 0, 0, 0);
                s1 = __builtin_amdgcn_mfma_f32_16x16x32_bf16(aq[kk], b1, s1, 0, 0, 0);
                ov = __builtin_amdgcn_mfma_f32_16x16x32_bf16(aq[kk], bq, ov, 0, 0, 0);
            }
            if (et == 0) {
#pragma unroll
                for (int kk = 0; kk < 8; ++kk) { const bf16x8 bn = *(const LAS bf16x8*)(lds + ML_CB + (32 + fr) * 528 + (kk * 32 + fq * 8) * 2);
                    ovn = __builtin_amdgcn_mfma_f32_16x16x32_bf16(aq[kk], bn, ovn, 0, 0, 0); }
                if (fr == 0) {
#pragma unroll
                    for (int j = 0; j < 4; ++j) sc_nq[mt * 16 + fq * 4 + j] = ovn[j]; }
            }
            {
                float rs[4] = {0.f, 0.f, 0.f, 0.f};
#pragma unroll
                for (int q = 0; q < 2; ++q) {
                    const int s = (ntp + q) * 16 + fr; const float as = sc_a[s];
#pragma unroll
                    for (int j = 0; j < 4; ++j) { const int t = mt * 16 + fq * 4 + j; const float wgt = (s <= t) ? __expf(as - sc_M[t]) * 0.0625f : 0.f;
                        const float pv = (q == 0 ? s0[j] : s1[j]) * wgt; rs[j] += pv; PB[t * 72 + s] = f2bf(pv); }
                }
#pragma unroll
                for (int j = 0; j < 4; ++j) { float v = row_sum16(rs[j]);
                    if (fr == 0) sc_rs[(w & 1) * 64 + mt * 16 + fq * 4 + j] = v; }
            }
            lds_barrier();
            float g[4];
#pragma unroll
            for (int j = 0; j < 4; ++j) { g[j] = __expf(m_prev - sc_M[mt * 16 + fq * 4 + j]); ov[j] *= g[j]; }
            {
                u32x2 v0 = trr(tr_vs), v1 = trr(tr_vs + 4 * 80), v2 = trr(tr_vs + 32 * 80), v3 = trr(tr_vs + 36 * 80);
                trw4(v0, v1, v2, v3);
                const bf16x8 a0 = *(const LAS bf16x8*)(lds + ML_PB + (mt * 16 + fr) * 144 + (fq * 8) * 2);
                const bf16x8 a1 = *(const LAS bf16x8*)(lds + ML_PB + (mt * 16 + fr) * 144 + (32 + fq * 8) * 2);
                ov = __builtin_amdgcn_mfma_f32_16x16x32_bf16(a0, mk8(v0, v1), ov, 0, 0, 0);
                ov = __builtin_amdgcn_mfma_f32_16x16x32_bf16(a1, mk8(v2, v3), ov, 0, 0, 0);
            }
#pragma unroll
            for (int j = 0; j < 4; ++j) {
                const int t = mt * 16 + fq * 4 + j; const float den = g[j] * sc_nq[t] + sc_rs[t] + sc_rs[64 + t];
                const float dn = fmaxf(fabsf(den), __expf(-(sc_b[t] + sc_M[t]))); const float hv = ov[j] * __builtin_amdgcn_rcpf(dn);
                cat[(r0 + t) * D + 512 + h * 256 + e0 + et * 16 + fr] = f2bf(hv);
                float sq = row_sum16(hv * hv);
                if (fr == 0) atomicAdd(hsq + (r0 + t) * 4 + h, sq);
            }
#pragma unroll
            for (int e2 = 0; e2 < 3; ++e2)
#pragma unroll
                for (int di = 0; di < 2; ++di) Cacc[e2][di] *= gs;
#pragma unroll
            for (int kk = 0; kk < 2; ++kk) {
                u32x2 k0 = trr(tr_k + kk * 32 * 528), k1 = trr(tr_k + kk * 32 * 528 + 4 * 528), k2 = trr(tr_k + kk * 32 * 528 + 32), k3 = trr(tr_k + kk * 32 * 528 + 4 * 528 + 32);
                trw4(k0, k1, k2, k3);
                const bf16x8 kb0 = mk8(k0, k1), kb1 = mk8(k2, k3);
#pragma unroll
                for (int e2 = 0; e2 < 3; ++e2) {
                    u32x2 a0 = trr(tr_vw + kk * 32 * 112 + e2 * 32), a1 = trr(tr_vw + kk * 32 * 112 + 4 * 112 + e2 * 32);
                    trw2(a0, a1);
                    const bf16x8 af = mk8(a0, a1);
                    Cacc[e2][0] = __builtin_amdgcn_mfma_f32_16x16x32_bf16(af, kb0, Cacc[e2][0], 0, 0, 0);
                    Cacc[e2][1] = __builtin_amdgcn_mfma_f32_16x16x32_bf16(af, kb1, Cacc[e2][1], 0, 0, 0);
                }
            }
#pragma unroll
            for (int e2 = 0; e2 < 3; ++e2)
#pragma unroll
                for (int di = 0; di < 2; ++di) {
                    const int dt = 2 * w + di; const f32x4 cc = Cacc[e2][di];
                    if (e2 < 2) {
#pragma unroll
                        for (int j = 0; j < 4; ++j) CB[(e2 * 16 + fq * 4 + j) * 264 + dt * 16 + fr] = f2bf(cc[j]);
                    } else if (fq == 0) CB[32 * 264 + dt * 16 + fr] = f2bf(cc[0]);
                }
            m_prev = m_new;
            lds_barrier();
        }
    }
}

constexpr int AT_K = 0, AT_V = 34816;
__device__ __forceinline__ void attn_phase(int wv, PP P, int L, LAS unsigned char* lds) {
    const int tid = opaque_tid(wv), w = __builtin_amdgcn_readfirstlane(tid >> 6), lane = tid & 63, fr = lane & 15, fq = lane >> 4;
    const bf16_t* zA = (const bf16_t*)(P->ws + WS_Z); bf16_t* cat = (bf16_t*)((unsigned char*)P->out + DO_HB);
    const float lam_init = 0.8f - 0.6f * expf(-0.3f * (float)L);
    float lam;
    { const float* lf = P->da_lambda + (size_t)L * 256; float x = lf[lane] * lf[64 + lane], y = lf[128 + lane] * lf[192 + lane];
#pragma unroll
      for (int o = 1; o < 64; o <<= 1) { x += shx(x, o, lane); y += shx(y, o, lane); }
      lam = expf(x) - expf(y) + lam_init; }
    const int trq = (lane >> 2) & 3, trp = lane & 3; const unsigned ldsb = (unsigned)(size_t)lds;
    for (int it = opaque_bid(); it < 544; it += gridDim.x) {
        int j, bh;
        if (it < 256) { j = 16 - (it >> 5); bh = it & 31; } else if (it < 512) { const int r = 511 - it; j = 8 - (r >> 5); bh = r & 31; } else { j = 0; bh = it - 512; }
        const int b = bh >> 2, h = bh & 3; const int q0 = j * 128 - 64; const bool wact = (j > 0) || (w >= 4);
        const size_t qrow = (size_t)b * LP + (wact ? q0 + w * 16 + fr : 0);
        bf16x8 qf[2][2];
#pragma unroll
        for (int m = 0; m < 2; ++m)
#pragma unroll
            for (int kk = 0; kk < 2; ++kk) qf[m][kk] = *(const bf16x8*)(zA + qrow * NZA + ZA_DQ + h * 128 + m * 64 + kk * 32 + fq * 8);
        f32x4 O[2][8]; float mrun[2], lrun[2];
#pragma unroll
        for (int m = 0; m < 2; ++m) {
#pragma unroll
            for (int e = 0; e < 8; ++e) O[m][e] = (f32x4){0.f, 0.f, 0.f, 0.f};
            mrun[m] = -INFINITY; lrun[m] = 0.f;
        }
        const int ktmax = 2 * j; const int my_last = !wact ? -1 : ((j >= 1 && w < 4) ? ktmax - 1 : ktmax);
        u32x4 kpre[2], vpre[2];
        auto fetchkv = [&](int kk_t) {
            const size_t kr = (size_t)b * LP + (size_t)kk_t * 64;
#pragma unroll
            for (int i = 0; i < 2; ++i) { const int id = tid + i * 512, s = id >> 4, c8 = (id & 15) * 8; kpre[i] = *(const u32x4*)(zA + (kr + s) * NZA + ZA_DK + h * 128 + c8); }
#pragma unroll
            for (int i = 0; i < 2; ++i) { const int id = tid + i * 512, s = id >> 4, c8 = (id & 15) * 8; vpre[i] = *(const u32x4*)(zA + (kr + s) * NZA + ZA_DV + h * 128 + c8); }
        };
        fetchkv(0);
        lds_barrier();
        for (int kt = 0; kt <= ktmax; ++kt) {
            const int kbuf = AT_K + (kt & 1) * 17408, vbuf = AT_V + (kt & 1) * 17408;
#pragma unroll
            for (int i = 0; i < 2; ++i) { const int id = tid + i * 512, s = id >> 4, c8 = (id & 15) * 8; *(LAS u32x4*)(lds + kbuf + s * 272 + c8 * 2) = kpre[i]; *(LAS u32x4*)(lds + vbuf + s * 272 + c8 * 2) = vpre[i]; }
            lds_barrier();
            if (kt < ktmax) fetchkv(kt + 1);
            if (kt <= my_last) {
                bf16x8 pf[2][2];
#pragma unroll
                for (int m = 0; m < 2; ++m) {
                    f32x4 sa[4];
#pragma unroll
                    for (int nt = 0; nt < 4; ++nt) { sa[nt] = (f32x4){0.f, 0.f, 0.f, 0.f};
#pragma unroll
                        for (int kk = 0; kk < 2; ++kk) { const bf16x8 kf = *(const LAS bf16x8*)(lds + kbuf + (nt * 16 + fr) * 272 + (m * 64 + kk * 32 + fq * 8) * 2);
                            sa[nt] = __builtin_amdgcn_mfma_f32_16x16x32_bf16(kf, qf[m][kk], sa[nt], 0, 0, 0); } }
                    float mx = -INFINITY;
#pragma unroll
                    for (int nt = 0; nt < 4; ++nt)
#pragma unroll
                        for (int q = 0; q < 4; ++q) { const bool kv = (kt > 0) || (nt * 16 + fq * 4 + q >= 48); sa[nt][q] = kv ? sa[nt][q] * (0.125f * 1.4426950408889634f) : -INFINITY; mx = fmaxf(mx, sa[nt][q]); }
                    mx = fmaxf(mx, shx(mx, 16, lane)); mx = fmaxf(mx, shx(mx, 32, lane));
                    const float mold = mrun[m]; const float mnew = fmaxf(mold, mx); const float alpha = __builtin_amdgcn_exp2f(mold - mnew); mrun[m] = mnew;
                    const bool grew = __builtin_amdgcn_ballot_w64(mnew != mold) != 0ull;
                    float rsum = 0.f;
#pragma unroll
                    for (int nt = 0; nt < 4; ++nt)
#pragma unroll
                        for (int q = 0; q < 4; ++q) { sa[nt][q] = __builtin_amdgcn_exp2f(sa[nt][q] - mnew); rsum += sa[nt][q]; }
                    rsum += shx(rsum, 16, lane); rsum += shx(rsum, 32, lane);
                    lrun[m] = lrun[m] * alpha + rsum;
#pragma unroll
                    for (int e = 0; e < 8; ++e) if (grew) O[m][e] *= alpha;
#pragma unroll
                    for (int kp = 0; kp < 2; ++kp) { u32x4 t; t.x = pack2(sa[2 * kp][0], sa[2 * kp][1]); t.y = pack2(sa[2 * kp][2], sa[2 * kp][3]); t.z = pack2(sa[2 * kp + 1][0], sa[2 * kp + 1][1]); t.w = pack2(sa[2 * kp + 1][2], sa[2 * kp + 1][3]);
                        pf[m][kp] = __builtin_bit_cast(bf16x8, t); }
                }
                const unsigned trv = ldsb + vbuf + (4 * fq + trq) * 272 + (4 * trp) * 2;
#pragma unroll
                for (int kp = 0; kp < 2; ++kp) {
                    u32x2 vl[8], vh[8];
#pragma unroll
                    for (int e = 0; e < 8; ++e) { vl[e] = trr(trv + (32 * kp) * 272 + e * 32); vh[e] = trr(trv + (32 * kp + 16) * 272 + e * 32); }
                    trw4(vl[0], vl[1], vl[2], vl[3]); trw4(vl[4], vl[5], vl[6], vl[7]); trw4(vh[0], vh[1], vh[2], vh[3]); trw4(vh[4], vh[5], vh[6], vh[7]);
#pragma unroll
                    for (int e = 0; e < 8; ++e) { const bf16x8 vf = mk8(vl[e], vh[e]);
                        O[0][e] = __builtin_amdgcn_mfma_f32_16x16x32_bf16(vf, pf[0][kp], O[0][e], 0, 0, 0);
                        O[1][e] = __builtin_amdgcn_mfma_f32_16x16x32_bf16(vf, pf[1][kp], O[1][e], 0, 0, 0); }
                }
            }
        }
        const float* dn = P->da_norm + (size_t)L * 128;
        const float i0 = __builtin_amdgcn_rcpf(lrun[0]), i1 = lam * __builtin_amdgcn_rcpf(lrun[1]); float ss = 0.f;
#pragma unroll
        for (int e = 0; e < 8; ++e) { O[0][e] = O[0][e] * i0 - O[1][e] * i1; ss += O[0][e][0] * O[0][e][0] + O[0][e][1] * O[0][e][1] + O[0][e][2] * O[0][e][2] + O[0][e][3] * O[0][e][3]; }
        ss += shx(ss, 16, lane); ss += shx(ss, 32, lane);
        const int pos = q0 + w * 16 + fr; const float r = (pos < PADN) ? 0.f : rsqrtf(ss * (1.0f / 128.0f) + EPS) * (1.0f - lam_init);
#pragma unroll
        for (int e = 0; e < 8; ++e) { const f32x4 g4 = *(const f32x4*)(dn + e * 16 + fq * 4); u32x2 o; o.x = pack2(O[0][e][0] * r * g4[0], O[0][e][1] * r * g4[1]); o.y = pack2(O[0][e][2] * r * g4[2], O[0][e][3] * r * g4[3]);
            if (pos < PADN) { o.x = 0u; o.y = 0u; }
            if (wact) *(u32x2*)(cat + ((size_t)b * LP + pos) * D + 1536 + h * 128 + e * 16 + fq * 4) = o; }
    }
}

__device__ __forceinline__ void fin_phase(int wv, PP P, int L) {
    const bf16_t* zA = (const bf16_t*)(P->ws + WS_Z); bf16_t* cat = (bf16_t*)((unsigned char*)P->out + DO_HB); const float* hsq = (const float*)(P->ws + WS_HSQ) + (size_t)L * MP * 4;
    const float* mn = P->ml_norm + (size_t)L * 1024; constexpr int total = MP * 128;
    const int nthr = gridDim.x * 512;
    for (int idx0 = opaque_bid() * 512 + opaque_tid(wv); idx0 < total; idx0 += 4 * nthr) {
        u32x4 raw[4], og[4]; float rr[4];
#pragma unroll
        for (int k = 0; k < 4; ++k) { const int idx = idx0 + k * nthr; if (idx < total) { const int row = idx >> 7, c = (idx & 127) * 8;
            raw[k] = *(const u32x4*)(cat + (size_t)row * D + 512 + c); og[k] = *(const u32x4*)(zA + (size_t)row * NZA + ZA_MO + c); rr[k] = hsq[(size_t)row * 4 + (c >> 8)]; } }
#pragma unroll
        for (int k = 0; k < 4; ++k) { const int idx = idx0 + k * nthr; if (idx < total) { const int row = idx >> 7, c = (idx & 127) * 8;
            const float r = rsqrtf(rr[k] * (1.0f / 256.0f) + EPS); const f32x4 w0 = *(const f32x4*)(mn + c), w1 = *(const f32x4*)(mn + c + 4); u32x4 o;
            o.x = pack2(lo16(raw[k].x) * r * w0[0] * sigm(lo16(og[k].x)), hi16(raw[k].x) * r * w0[1] * sigm(hi16(og[k].x)));
            o.y = pack2(lo16(raw[k].y) * r * w0[2] * sigm(lo16(og[k].y)), hi16(raw[k].y) * r * w0[3] * sigm(hi16(og[k].y)));
            o.z = pack2(lo16(raw[k].z) * r * w1[0] * sigm(lo16(og[k].z)), hi16(raw[k].z) * r * w1[1] * sigm(hi16(og[k].z)));
            o.w = pack2(lo16(raw[k].w) * r * w1[2] * sigm(lo16(og[k].w)), hi16(raw[k].w) * r * w1[3] * sigm(hi16(og[k].w)));
            *(u32x4*)(cat + (size_t)row * D + 512 + c) = o; } }
    }
}

__device__ __forceinline__ void act_phase(int wv, PP P, int L) {
    bf16_t* z2 = (bf16_t*)(P->ws + WS_Z); const float* cw = P->conv_ffn + (size_t)L * 3 * DFF; const float* cb = P->conv_ffn_b + (size_t)L * DFF;
    constexpr int NCG = DFF / 8, NCH = 176, RPC = 96;
    const int id = opaque_bid() * 512 + opaque_tid(wv);
    if (id >= NCG * NCH) return;
    const int c = (id % NCG) * 8, ch = id / NCG; const int r0 = ch * RPC, r1 = (r0 + RPC < MP) ? r0 + RPC : MP;
    float w0[8], w1[8], w2[8], bs[8];
    { const f32x4 a0 = *(const f32x4*)(cw + c), a1 = *(const f32x4*)(cw + c + 4), b0 = *(const f32x4*)(cw + DFF + c), b1 = *(const f32x4*)(cw + DFF + c + 4), c0 = *(const f32x4*)(cw + 2 * DFF + c), c1 = *(const f32x4*)(cw + 2 * DFF + c + 4), d0 = *(const f32x4*)(cb + c), d1 = *(const f32x4*)(cb + c + 4);
#pragma unroll
      for (int i = 0; i < 4; ++i) { w0[i] = a0[i]; w0[4 + i] = a1[i]; w1[i] = b0[i]; w1[4 + i] = b1[i]; w2[i] = c0[i]; w2[4 + i] = c1[i]; bs[i] = d0[i]; bs[4 + i] = d1[i]; } }
    u32x4 am2 = zero4(), am1 = zero4();
    if (r0 >= 2) { am2 = *(const u32x4*)(z2 + (size_t)(r0 - 2) * NUP + c); am1 = *(const u32x4*)(z2 + (size_t)(r0 - 1) * NUP + c); }
    for (int row = r0; row < r1; row += 4) {
        u32x4 av[4], bv[4];
#pragma unroll
        for (int k = 0; k < 4; ++k) { av[k] = *(const u32x4*)(z2 + (size_t)(row + k) * NUP + c); bv[k] = *(const u32x4*)(z2 + (size_t)(row + k) * NUP + DFF + c); }
#pragma unroll
        for (int k = 0; k < 4; ++k) {
            const u32x4 a0 = av[k], bb = bv[k]; float y[8];
#pragma unroll
            for (int q = 0; q < 4; ++q) {
                y[2 * q] = bs[2 * q] + w0[2 * q] * lo16(am2[q]) + w1[2 * q] * lo16(am1[q]) + w2[2 * q] * lo16(a0[q]);
                y[2 * q + 1] = bs[2 * q + 1] + w0[2 * q + 1] * hi16(am2[q]) + w1[2 * q + 1] * hi16(am1[q]) + w2[2 * q + 1] * hi16(a0[q]);
            }
            u32x4 o;
#pragma unroll
            for (int q = 0; q < 4; ++q) o[q] = pack2(gelu_as(y[2 * q]) * lo16(bb[q]), gelu_as(y[2 * q + 1]) * hi16(bb[q]));
            *(u32x4*)(z2 + (size_t)(row + k) * NUP + DFF + c) = o;
            am2 = am1; am1 = a0;
        }
    }
}

__device__ __forceinline__ void final_phase(int wv, PP P) {
    const float* hp = (const float*)(P->ws + WS_HP); const float* rsq = (const float*)(P->ws + WS_RSQ) + (size_t)4 * MP;
    const int tid = opaque_tid(wv), w = tid >> 6, lane = tid & 63;
    for (int orow = blockIdx.x * 8 + w; orow < NB * SEQ; orow += gridDim.x * 8) {
        const int b = orow / SEQ, s = orow % SEQ; const size_t row = (size_t)b * LP + LEADR + s; const float r = rsqrtf(rsq[row] * (1.0f / D) + EPS);
#pragma unroll
        for (int i = 0; i < 8; ++i) { const int c = (i * 64 + lane) * 4; const f32x4 v = *(const f32x4*)(hp + row * D + c), g = *(const f32x4*)(P->norm_f + c);
            *(f32x4*)(P->out + (size_t)orow * D + c) = v * g * r; }
    }
}


#define XB_TMO      128
#define XB_XCNT(j)  (256  + 64 * (j))
#define XB_XSUB(j)  (1280 + 64 * (j))
#define XB_XGEN(j)  (2304 + 64 * (j))
#define XB_TOP      3328
#define XB_TOPGEN   3392
#define XB_SPIN_CAP (1u << 18)
__device__ __forceinline__ unsigned xb_ld(unsigned* p)              { return __hip_atomic_load(p, __ATOMIC_RELAXED, __HIP_MEMORY_SCOPE_AGENT); }
__device__ __forceinline__ unsigned xb_add(unsigned* p, unsigned v) { return __hip_atomic_fetch_add(p, v, __ATOMIC_RELAXED, __HIP_MEMORY_SCOPE_AGENT); }
__device__ __forceinline__ unsigned xb_xcc_id() { return (unsigned)__builtin_amdgcn_s_getreg((3 << 11) | 20) & 0xFu; }
#define XB_SPIN(cond, bar) do { unsigned _sp = 0; while (cond) { __builtin_amdgcn_s_sleep(1); \
    if ((++_sp & 255u) == 0u) { if (xb_ld(&(bar)[XB_TMO])) break; if (_sp > XB_SPIN_CAP) { atomicAdd(&(bar)[XB_TMO], 1u); break; } } } } while (0)
__device__ __forceinline__ void xcd_barrier_complete(unsigned* bar, unsigned x, unsigned& nloc, unsigned& nx) {
    const unsigned G = gridDim.x * gridDim.y * gridDim.z;
    unsigned sum, cnt, mine, sp = 0u;
    for (;;) {
        sum = 0u; cnt = 0u; mine = 0u;
#pragma unroll
        for (unsigned j = 0; j < 16; ++j) { const unsigned c = xb_ld(&bar[XB_XCNT(j)]); sum += c; cnt += (c > 0u) ? 1u : 0u; mine = (j == x) ? c : mine; }
        if (sum == G) break;
        __builtin_amdgcn_s_sleep(1);
        if ((++sp & 255u) == 0u) { if (xb_ld(&bar[XB_TMO])) break; if (sp > XB_SPIN_CAP) { atomicAdd(&bar[XB_TMO], 1u); break; } }
    }
    nloc = mine > 0u ? mine : 1u; nx = cnt > 0u ? cnt : 1u;
}
__device__ __forceinline__ void gbar_post(int wv, LAS unsigned char* lds) {
    const int tid = opaque_tid(wv); unsigned* bar = (unsigned*)(get_params()->ws + WS_BAR);
    if (tid == 0) { volatile LAS unsigned* st = (volatile LAS unsigned*)(lds + LDS_ST); st[0] = 0u; st[1] = 0u;
        (void)xb_add(&bar[XB_XCNT(xb_xcc_id())], 1u); }
    __syncthreads();
}
__device__ __forceinline__ void gbar(int wv, LAS unsigned char* lds) {
    asm volatile("s_waitcnt vmcnt(0)" ::: "memory");
    __syncthreads();
    const int tid = opaque_tid(wv); unsigned* bar = (unsigned*)(get_params()->ws + WS_BAR);
    if (tid == 0) {
        volatile LAS unsigned* st = (volatile LAS unsigned*)(lds + LDS_ST); const unsigned x = xb_xcc_id();
        __builtin_amdgcn_s_waitcnt(0);
        unsigned nloc = st[0], nx = st[1];
        if (nloc == 0u) { xcd_barrier_complete(bar, x, nloc, nx); st[0] = nloc; st[1] = nx; }
        const unsigned old = xb_add(&bar[XB_XSUB(x)], 1u);
        const unsigned gen = old / nloc;
        if (old + 1u == (gen + 1u) * nloc) {
            __builtin_amdgcn_fence(__ATOMIC_RELEASE, "agent");
            asm volatile("s_waitcnt vmcnt(0)" ::: "memory");
            const unsigned og = xb_add(&bar[XB_TOP], 1u);
            const unsigned tg = og / nx;
            if (og + 1u == (tg + 1u) * nx) xb_add(&bar[XB_TOPGEN], 1u);
            else XB_SPIN(xb_ld(&bar[XB_TOPGEN]) == tg, bar);
            __builtin_amdgcn_fence(__ATOMIC_ACQUIRE, "agent");
            xb_add(&bar[XB_XGEN(x)], 1u);
            asm volatile("s_waitcnt vmcnt(0)" ::: "memory");
        } else {
            XB_SPIN(xb_ld(&bar[XB_XGEN(x)]) == gen, bar);
            __builtin_amdgcn_fence(__ATOMIC_ACQUIRE, "agent");
            asm volatile("s_waitcnt vmcnt(0)" ::: "memory");
        }
    }
    __syncthreads();
}

__device__ __forceinline__ void fill_convert(int wv, LAS unsigned char* lds, int nunits, int L, int mask) {
    const int G = (int)gridDim.x, extra = nunits % G, bid = opaque_bid();
    if (extra != 0 && bid >= extra) convert_layer(wv, get_params(), L, mask, (LAS float*)lds, bid - extra, G - extra);
}
__device__ __forceinline__ void ph_gemm_in(int wv, LAS unsigned char* lds, int L) {
    PP P = get_params(); unsigned char* ws = P->ws; unsigned char* dob = (unsigned char*)P->out;
    EpiZ e; e.zA = (bf16_t*)(ws + WS_Z); e.zG = (bf16_t*)(ws + WS_ZG); e.gates = (float*)(ws + WS_GATES); e.rsq = (float*)(ws + WS_RSQ) + (size_t)(2 * L) * MP;
    run_gemm<D, D, MP, NZ, D>(wv, lds, (const bf16_t*)(dob + DO_HB), (const bf16_t*)(ws + WS_WIN), e);
    if (L == 0) fill_convert(wv, lds, (MP / 256) * (NZ / 256), 0, 2 | 4);
}
__device__ __forceinline__ void ph_gemm_merge(int wv, LAS unsigned char* lds, int L) {
    PP P = get_params(); unsigned char* ws = P->ws; unsigned char* dob = (unsigned char*)P->out;
    EpiMerge e; e.zG = (const bf16_t*)(ws + WS_ZG); e.mb = (bf16_t*)(ws + WS_Z);
    run_gemm<D, D, MP, D, D>(wv, lds, (const bf16_t*)(dob + DO_HB), (const bf16_t*)(dob + DO_WBR), e);
    fill_convert(wv, lds, (MP / 256) * (D / 256), L, L == 0 ? (8 | 16) : 16);
}
__device__ __forceinline__ void ph_gemm_out(int wv, LAS unsigned char* lds, int L) {
    PP P = get_params(); unsigned char* ws = P->ws; unsigned char* dob = (unsigned char*)P->out;
    EpiResid e; e.h = (float*)(ws + WS_HP); e.hb = (bf16_t*)(dob + DO_HB); e.rsqn = (float*)(ws + WS_RSQ) + (size_t)(2 * L + 1) * MP;
    run_gemm<D, D, MP, D, D>(wv, lds, (const bf16_t*)(ws + WS_Z), (const bf16_t*)(dob + DO_WOUT), e);
    if (L == 0) fill_convert(wv, lds, (MP / 256) * (D / 256), 1, 1);
}
__device__ __forceinline__ void ph_gemm_up(int wv, LAS unsigned char* lds, int L) {
    PP P = get_params(); unsigned char* ws = P->ws; unsigned char* dob = (unsigned char*)P->out;
    EpiUp e; e.z2 = (bf16_t*)(ws + WS_Z); e.rsq = (const float*)(ws + WS_RSQ) + (size_t)(2 * L + 1) * MP;
    run_gemm<D, D, MP, NUP, D>(wv, lds, (const bf16_t*)(dob + DO_HB), (const bf16_t*)(dob + DO_WUP), e);
    if (L == 0) fill_convert(wv, lds, (MP / 256) * (NUP / 256), 1, 2 | 4);
}
__device__ __forceinline__ void ph_gemm_down(int wv, LAS unsigned char* lds, int L) {
    PP P = get_params(); unsigned char* ws = P->ws; unsigned char* dob = (unsigned char*)P->out;
    EpiResid e; e.h = (float*)(ws + WS_HP); e.hb = (bf16_t*)(dob + DO_HB); e.rsqn = (float*)(ws + WS_RSQ) + (size_t)(2 * L + 2) * MP;
    run_gemm<NUP, DFF, MP, D, DFF>(wv, lds, (const bf16_t*)(ws + WS_Z) + DFF, (const bf16_t*)(ws + WS_WDOWN), e);
    if (L == 0) fill_convert(wv, lds, (MP / 256) * (D / 256), 1, 8);
}

__global__ void __launch_bounds__(512, 2) fwd_megakernel(Params p_unused) {
    extern __shared__ __attribute__((aligned(16))) unsigned char smem[];
    LAS unsigned char* lds = (LAS unsigned char*)smem;
    cg::grid_group grid = cg::this_grid();
    const int wv = __builtin_amdgcn_readfirstlane((int)threadIdx.x >> 6);
    gbar_post(wv, lds);
    convert_layer(wv, get_params(), 0, 1, (LAS float*)lds, opaque_bid(), (int)gridDim.x);
    init_phase(wv, get_params());
    if (get_params()->ws == nullptr) grid.sync();
    gbar(wv, lds);
#pragma unroll
    for (int L = 0; L < 2; ++L) {
        ph_gemm_in(wv, lds, L);
        gbar(wv, lds);
        conva_phase(wv, get_params(), L);
        mlstm_phase(wv, get_params(), L, lds);
        attn_phase(wv, get_params(), L, lds);
        gbar(wv, lds);
        fin_phase(wv, get_params(), L);
        gbar(wv, lds);
        ph_gemm_merge(wv, lds, L);
        gbar(wv, lds);
        ph_gemm_out(wv, lds, L);
        gbar(wv, lds);
        ph_gemm_up(wv, lds, L);
        gbar(wv, lds);
        act_phase(wv, get_params(), L);
        gbar(wv, lds);
        ph_gemm_down(wv, lds, L);
        gbar(wv, lds);
    }
    final_phase(wv, get_params());
}

extern "C" void kernel_launch(void* const* d_in, const int* in_sizes, int n_in, void* d_out, int out_size, void* d_ws, size_t ws_size, hipStream_t stream) {
    static int grid_blocks = 0;
    if (grid_blocks == 0) {
        if (n_in != 19 || ws_size < WS_END) { fprintf(stderr, "kernel_launch: unexpected inputs (n_in %d, ws %zu, need %zu)\n", n_in, ws_size, (size_t)WS_END); grid_blocks = -1; return; }
        int dev = 0, cus = 0, per_cu = 0;
        hipGetDevice(&dev); hipDeviceGetAttribute(&cus, hipDeviceAttributeMultiprocessorCount, dev);
        if (hipFuncSetAttribute((const void*)fwd_megakernel, hipFuncAttributeMaxDynamicSharedMemorySize, LDS_BYTES) != hipSuccess) { fprintf(stderr, "kernel_launch: hipFuncSetAttribute failed\n"); grid_blocks = -1; return; }
        hipOccupancyMaxActiveBlocksPerMultiprocessor(&per_cu, (const void*)fwd_megakernel, 512, LDS_BYTES);
        if (per_cu < 1) per_cu = 1;
        grid_blocks = cus * per_cu;
        if (grid_blocks > 256) grid_blocks = 256;
    }
    if (grid_blocks < 0) return;
    Params p{};
    const float** pp = (const float**)&p;
    for (int i = 0; i < 19; ++i) pp[i] = (const float*)d_in[i];
    p.out = (float*)d_out; p.ws = (unsigned char*)d_ws;
    (void)hipMemsetAsync((char*)d_ws + WS_BAR, 0, 3456 * 4, stream);
    void* args[] = {&p};
    hipError_t e = hipLaunchCooperativeKernel((const void*)fwd_megakernel, dim3(grid_blocks), dim3(512), args, LDS_BYTES, stream);
    if (e != hipSuccess) fprintf(stderr, "cooperative launch failed: %s (grid %d)\n", hipGetErrorString(e), grid_blocks);
}
```

```cpp
#include <hip/hip_runtime.h>
#include <hip/hip_cooperative_groups.h>
#include <cstdio>
namespace cg = cooperative_groups;

#define LAS __attribute__((address_space(3)))
typedef unsigned short bf16_t;
typedef short bf16x8 __attribute__((ext_vector_type(8)));
typedef float f32x4 __attribute__((ext_vector_type(4)));
typedef unsigned u32x4 __attribute__((ext_vector_type(4)));
typedef unsigned u32x2 __attribute__((ext_vector_type(2)));

constexpr int D = 2048, NB = 8, SEQ = 2048, LP = 2112, MP = NB * LP  , PADN = 48, LEADR = 64  ;
constexpr int DIN = 13320, NZ = 13568, NZA = 7168, NZG = 6144;
constexpr int DFF = 5632, NUP = 11264;
constexpr float EPS = 1e-6f;
constexpr int ZA_AX = 0, ZA_AB = 512, ZA_AC = 1024, ZA_MQ = 1536, ZA_MK = 2560, ZA_MV = 3584, ZA_MO = 4608, ZA_DQ = 5632, ZA_DK = 6144, ZA_DV = 6656;
constexpr size_t WS_HP = 0;
constexpr size_t WS_Z = WS_HP + (size_t)MP * D * 4;
constexpr size_t WS_ZG = WS_Z + (size_t)MP * NZA * 2;
constexpr size_t WS_WIN = WS_Z + (size_t)MP * (NZA + NZG) * 2;
constexpr size_t WS_WDOWN = WS_WIN + (size_t)NZ * D * 2;
constexpr size_t WS_GATES = WS_WDOWN + (size_t)D * DFF * 2;
constexpr size_t WS_RSQ = WS_GATES + (size_t)MP * 8 * 4;
constexpr size_t WS_HSQ = WS_RSQ + (size_t)5 * MP * 4;
constexpr size_t WS_GSC = WS_HSQ + (size_t)2 * MP * 4 * 4;
constexpr size_t WS_BAR = WS_GSC + (size_t)256 * 34 * 64 * 16;
constexpr size_t WS_END = WS_BAR + 3456 * 4;
constexpr size_t DO_HB = 0;
constexpr size_t DO_WBR = (size_t)MP * D * 2;
constexpr size_t DO_WOUT = DO_WBR + (size_t)D * D * 2;
constexpr size_t DO_WUP = DO_WOUT + (size_t)D * D * 2;
static_assert(DO_WUP + (size_t)NUP * D * 2 <= (size_t)NB * SEQ * D * 4, "d_out scratch overflow");

constexpr int LDS_BYTES = 152576;
constexpr int LDS_ST = LDS_BYTES - 16;

struct Params {
    const float *x, *meta, *norm_mix, *w_in, *conv_a, *b_if, *ml_norm, *da_lambda, *da_norm, *w_br_a, *w_br_m, *w_br_d, *w_out, *norm_ffn, *w_up, *conv_ffn, *conv_ffn_b, *w_down, *norm_f;
    float* out; unsigned char* ws;
};

typedef const __attribute__((address_space(4))) Params* PP;
__device__ __forceinline__ PP get_params() { unsigned long long kp = (unsigned long long)__builtin_amdgcn_kernarg_segment_ptr(); asm volatile("" : "+s"(kp)); return (PP)kp; }
__device__ __forceinline__ int opaque_tid(int wv) { asm volatile("" : "+s"(wv)); unsigned z = 0u; asm volatile("" : "+v"(z)); const int l = __builtin_amdgcn_mbcnt_hi(~0u, __builtin_amdgcn_mbcnt_lo(~0u, z)); return (wv << 6) | l; }
__device__ __forceinline__ int opaque_bid() { int t = blockIdx.x; asm volatile("" : "+s"(t)); return t; }
__device__ __forceinline__ float shx(float v, int mask, int lane) { return __int_as_float(__builtin_amdgcn_ds_bpermute((lane ^ mask) << 2, __float_as_int(v))); }
__device__ __forceinline__ float shup(float v, int o, int lane) { return __int_as_float(__builtin_amdgcn_ds_bpermute((lane >= o ? lane - o : lane) << 2, __float_as_int(v))); }
__device__ __forceinline__ float shidx(float v, int src) { return __int_as_float(__builtin_amdgcn_ds_bpermute(src << 2, __float_as_int(v))); }
__device__ __forceinline__ u32x2 trr(unsigned addr) { u32x2 r; asm volatile("ds_read_b64_tr_b16 %0, %1" : "=&v"(r) : "v"(addr) : "memory"); return r; }
__device__ __forceinline__ void trw2(u32x2& a, u32x2& b) { asm volatile("s_waitcnt lgkmcnt(0)" : "+v"(a), "+v"(b) : : "memory"); }
__device__ __forceinline__ void trw4(u32x2& a, u32x2& b, u32x2& c, u32x2& d) { asm volatile("s_waitcnt lgkmcnt(0)" : "+v"(a), "+v"(b), "+v"(c), "+v"(d) : : "memory"); }
__device__ __forceinline__ bf16x8 mk8(const u32x2& lo, const u32x2& hi) { u32x4 t; t.x = lo.x; t.y = lo.y; t.z = hi.x; t.w = hi.y; return __builtin_bit_cast(bf16x8, t); }
__device__ __forceinline__ void lds_barrier() { asm volatile("s_waitcnt lgkmcnt(0)" ::: "memory"); __builtin_amdgcn_s_barrier(); asm volatile("" ::: "memory"); }
template <int CTRL> __device__ __forceinline__ float dppmov(float v) { return __builtin_bit_cast(float, __builtin_amdgcn_update_dpp(0, __builtin_bit_cast(int, v), CTRL, 0xF, 0xF, true)); }
__device__ __forceinline__ float row_sum16(float v) { v += dppmov<0xB1>(v); v += dppmov<0x4E>(v); v += dppmov<0x141>(v); v += dppmov<0x140>(v); return v; }
__device__ __forceinline__ u32x4 zero4() { unsigned z; asm volatile("v_mov_b32 %0, 0" : "=v"(z)); return (u32x4){z, z, z, z}; }
__device__ __forceinline__ float bf2f(bf16_t v) { return __uint_as_float(((unsigned)v) << 16); }

__device__ __forceinline__ unsigned pack2(float lo, float hi) { unsigned r; asm("v_cvt_pk_bf16_f32 %0, %1, %2" : "=v"(r) : "v"(lo), "v"(hi)); return r; }
__device__ __forceinline__ bf16_t f2bf(float f) { return (bf16_t)(pack2(f, f) & 0xffffu); }
__device__ __forceinline__ float lo16(unsigned w) { return __uint_as_float(w << 16); }
__device__ __forceinline__ float hi16(unsigned w) { return __uint_as_float(w & 0xffff0000u); }
__device__ __forceinline__ float gelu_as(float v) {
    const float av = fabsf(v), t = __builtin_amdgcn_rcpf(av * 0.2316418882f + 1.0f);
    float q = t * 0.5307027145f + (-0.7265760135f); q = q * t + 0.7107068705f; q = q * t + (-0.142248368f); q = q * t + 0.127414796f; q = q * t;
    const float e = __builtin_amdgcn_exp2f(v * v * (-0.72134752044f)); const float m = v * (q * e);
    return v < 0.f ? m : v - m;
}
__device__ __forceinline__ float sigm(float x) { return __builtin_amdgcn_rcpf(1.0f + __expf(-x)); }

namespace pg8 {
constexpr int BM = 256, BK = 64, HALF = 128, HTB = HALF * BK * 2, STAGE_BYTES = 8 * HTB, NXCD = 8, WGM = 8;
__device__ __forceinline__ int lds_byte(int r, int c) { const int st = (r >> 4) * 2 + (c >> 5), rr = r & 15, cc = c & 31, ob = rr * 64 + cc * 2; return st * 1024 + (ob ^ (((ob >> 9) & 1) << 5)); }
__device__ __forceinline__ void stage_rc(int b, int& R, int& C) { const int st = b / 1024, sb = b % 1024, swz = sb ^ (((sb >> 9) & 1) << 5); R = (st >> 1) * 16 + swz / 64; C = (st & 1) * 32 + (swz % 64) / 2; }
__device__ __forceinline__ int perm32(int rho) { const int n = rho >> 4, i = rho & 15; return 8 * (i >> 2) + 4 * n + (i & 3); }
struct Unit { int pm, pn; };
struct Gemm { const bf16_t* A; const bf16_t* Bt; };
struct StaticOrder {
    int nM, nN, nwg, G, c;
    __device__ void init(int M, int N, int G_, int c_) { nM = M / BM; nN = N / BM; nwg = nM * nN; G = G_; c = c_; }
    __device__ bool next(int i, Unit& u) const {
        const long L = (long)i * G + c; if (L >= nwg) return false;
        int wgid = (int)L; { const int q = nwg / NXCD, r = nwg % NXCD, xcd = wgid % NXCD, off = wgid / NXCD; wgid = (xcd < r ? xcd * (q + 1) : r * (q + 1) + (xcd - r) * q) + off; }
        const int nig = WGM * nN, gid = wgid / nig, fm = gid * WGM, gsz = (nM - fm) < WGM ? (nM - fm) : WGM;
        u.pm = fm + ((wgid % nig) % gsz); u.pn = (wgid % nig) / gsz; return true;
    }
};
template <class Epi, int LDA, int LDB, int KK>
__device__ __forceinline__ void gemm_phase(int wv, LAS unsigned char* lds, const Gemm g, const StaticOrder& S, const Epi& E) {
    const int tid = opaque_tid(wv), wid = __builtin_amdgcn_readfirstlane(tid >> 6), lane = tid & 63, wr = wid >> 2, wc = wid & 3, fr = lane & 15, fq = lane >> 4;
    constexpr int nt = KK / BK;
    unsigned voffA[2], voffB[2];
#pragma unroll
    for (int i = 0; i < 2; ++i) { int R, C; stage_rc(tid * 16 + i * 8192, R, C); const int Rb = (R & ~31) + perm32(R & 31);
        voffA[i] = (unsigned)(R * LDA + C) * 2u; voffB[i] = (unsigned)(Rb * LDB + C) * 2u; }
    constexpr size_t kstep = (size_t)(BK * 2);
    constexpr size_t hstepA = (size_t)HALF * LDA * 2, hstepB = (size_t)HALF * LDB * 2;
    constexpr size_t tstepA = 2 * hstepA, tstepB = 2 * hstepB;
    const unsigned ldsw = (unsigned)wid * 1024u;
    const int aoff = lds_byte(wr * 64 + fr, fq * 8), boff = lds_byte(wc * 32 + fr, fq * 8);
#define PG8_SA(b, h) (((b) * 2 + (h)) * HTB)
#define PG8_SB(b, h) ((4 + (b) * 2 + (h)) * HTB)
#define PG8_STAGE(bufoff, gbase, voff) do { _Pragma("unroll") for (int _i = 0; _i < 2; ++_i) \
        __builtin_amdgcn_global_load_lds((const unsigned*)((const char*)(gbase) + (voff)[_i]), (LAS unsigned*)(lds + (bufoff) + ldsw + _i * 8192), 16, 0, 0); } while (0)
#define PG8_LDA(dst, b, h) do { _Pragma("unroll") for (int m = 0; m < 4; ++m) _Pragma("unroll") for (int k = 0; k < 2; ++k) dst[m][k] = *(const LAS bf16x8*)(lds + PG8_SA(b, h) + aoff + m * 2048 + k * 1024); } while (0)
#define PG8_LDB(dst, b, h) do { _Pragma("unroll") for (int n = 0; n < 2; ++n) _Pragma("unroll") for (int k = 0; k < 2; ++k) dst[n][k] = *(const LAS bf16x8*)(lds + PG8_SB(b, h) + boff + n * 2048 + k * 1024); } while (0)
#define PG8_MMA(ai, bj, At, Bt) do { __builtin_amdgcn_s_setprio(1); _Pragma("unroll") for (int m = 0; m < 4; ++m) _Pragma("unroll") for (int n = 0; n < 2; ++n) _Pragma("unroll") for (int k = 0; k < 2; ++k) \
        acc[ai][bj][m][n] = __builtin_amdgcn_mfma_f32_16x16x32_bf16(Bt[n][k], At[m][k], acc[ai][bj][m][n], 0, 0, 0); __builtin_amdgcn_s_setprio(0); } while (0)
#define PG8_WAIT_V(n) asm volatile("s_waitcnt vmcnt(" #n ")" ::: "memory")
#define PG8_WAIT_L(n) asm volatile("s_waitcnt lgkmcnt(" #n ")" ::: "memory")
#define PG8_BAR __builtin_amdgcn_s_barrier()
#define PG8_SCHED __builtin_amdgcn_sched_barrier(0)
    Unit cur, nxt; int ui = 0;
    if (!S.next(0, cur)) return;
    f32x4 acc[2][2][4][2];
#pragma unroll
    for (int a = 0; a < 2; ++a)
#pragma unroll
        for (int b = 0; b < 2; ++b)
#pragma unroll
            for (int m = 0; m < 4; ++m)
#pragma unroll
                for (int n = 0; n < 2; ++n) acc[a][b][m][n] = (f32x4){0.f, 0.f, 0.f, 0.f};
    bf16x8 At[4][2], B0[2][2], B1[2][2];
    const char* cA = (const char*)g.A + (size_t)cur.pm * tstepA; const char* cB = (const char*)g.Bt + (size_t)cur.pn * tstepB;
    if constexpr (Epi::ROWSCALE) { if (wid < 4) __builtin_amdgcn_global_load_lds((const unsigned*)(E.rsq + cur.pm * 256 + wid * 64 + lane), (LAS unsigned*)(lds + 131072 + wid * 256), 4, 0, 0); }
    PG8_STAGE(PG8_SB(0, 0), cB, voffB); PG8_STAGE(PG8_SA(0, 0), cA, voffA); PG8_STAGE(PG8_SB(0, 1), cB + hstepB, voffB); PG8_STAGE(PG8_SA(0, 1), cA + hstepA, voffA);
    if (wr == 1) PG8_BAR;
    PG8_WAIT_V(4); PG8_BAR;
    PG8_STAGE(PG8_SB(1, 0), cB + kstep, voffB); PG8_STAGE(PG8_SA(1, 0), cA + kstep, voffA); PG8_STAGE(PG8_SB(1, 1), cB + hstepB + kstep, voffB);
    PG8_WAIT_V(6); PG8_BAR;
    for (;;) {
        const bool has_next = S.next(ui + 1, nxt);
        const char* nA = has_next ? (const char*)g.A + (size_t)nxt.pm * tstepA : cA; const char* nB = has_next ? (const char*)g.Bt + (size_t)nxt.pn * tstepB : cB;
        if constexpr (Epi::ROWSCALE) { if (has_next && wid < 4) __builtin_amdgcn_global_load_lds((const unsigned*)(E.rsq + nxt.pm * 256 + wid * 64 + lane), (LAS unsigned*)(lds + 131072 + ((ui + 1) % 3) * 1024 + wid * 256), 4, 0, 0); }
        for (int seg = 0, t = 0; seg < Epi::NSEG; ++seg) {
          const int tend = Epi::HAS_MID ? (seg == 0 ? Epi::MID1 : (seg == 1 ? Epi::MID2 : nt)) : nt;
          for (; t < tend; t += 2) {
            const bool last = (t == nt - 2);
            const char* a1 = cA + (size_t)(t + 1) * kstep;
            const char* a2 = last ? nA : cA + (size_t)(t + 2) * kstep; const char* b2 = last ? nB : cB + (size_t)(t + 2) * kstep;
            const char* a3 = a2 + kstep; const char* b3 = b2 + kstep;
            PG8_LDB(B0, 0, 0); PG8_SCHED; PG8_LDA(At, 0, 0); PG8_STAGE(PG8_SA(1, 1), a1 + hstepA, voffA);
            PG8_WAIT_L(8); PG8_BAR; PG8_WAIT_L(0); PG8_MMA(0, 0, At, B0); PG8_BAR; PG8_SCHED;
            PG8_LDB(B1, 0, 1); PG8_STAGE(PG8_SB(0, 0), b2, voffB);
            PG8_BAR; PG8_WAIT_L(0); PG8_MMA(0, 1, At, B1); PG8_BAR;
            PG8_LDA(At, 0, 1); PG8_STAGE(PG8_SA(0, 0), a2, voffA);
            PG8_BAR; PG8_WAIT_L(0); PG8_MMA(1, 0, At, B0); PG8_BAR; PG8_SCHED;
            PG8_STAGE(PG8_SB(0, 1), b2 + hstepB, voffB);
            PG8_WAIT_V(6); PG8_BAR; PG8_MMA(1, 1, At, B1); PG8_BAR;
            PG8_LDB(B0, 1, 0); PG8_SCHED; PG8_LDA(At, 1, 0); PG8_STAGE(PG8_SA(0, 1), a2 + hstepA, voffA);
            PG8_WAIT_L(8); PG8_BAR; PG8_WAIT_L(0); PG8_MMA(0, 0, At, B0); PG8_BAR; PG8_SCHED;
            PG8_LDB(B1, 1, 1); PG8_STAGE(PG8_SB(1, 0), b3, voffB);
            PG8_BAR; PG8_WAIT_L(0); PG8_MMA(0, 1, At, B1); PG8_BAR;
            PG8_LDA(At, 1, 1); PG8_STAGE(PG8_SA(1, 0), a3, voffA);
            PG8_BAR; PG8_WAIT_L(0); PG8_MMA(1, 0, At, B0); PG8_BAR; PG8_SCHED;
            PG8_STAGE(PG8_SB(1, 1), b3 + hstepB, voffB);
            PG8_WAIT_V(6); PG8_BAR; PG8_MMA(1, 1, At, B1); PG8_BAR;
          }
          if constexpr (Epi::HAS_MID) { if (seg < Epi::NSEG - 1) E.mid(acc, cur, seg, wr, wc, fr, fq); }
        }
        E(acc, cur, wr, wc, fr, fq, (const LAS float*)(lds + 131072 + (ui % 3) * 1024));
        if (!has_next) break;
#pragma unroll
        for (int a = 0; a < 2; ++a)
#pragma unroll
            for (int b = 0; b < 2; ++b)
#pragma unroll
                for (int m = 0; m < 4; ++m)
#pragma unroll
                    for (int n = 0; n < 2; ++n) acc[a][b][m][n] = (f32x4){0.f, 0.f, 0.f, 0.f};
        cur = nxt; cA = nA; cB = nB; ++ui;
    }
    PG8_WAIT_V(0);
    if (wr == 0) PG8_BAR;
    PG8_BAR;
#undef PG8_SA
#undef PG8_SB
#undef PG8_STAGE
#undef PG8_LDA
#undef PG8_LDB
#undef PG8_MMA
#undef PG8_WAIT_V
#undef PG8_WAIT_L
#undef PG8_BAR
#undef PG8_SCHED
}
}

typedef f32x4 AccT[2][2][4][2];

__device__ __forceinline__ u32x4 pack8(const f32x4& a, const f32x4& b) { u32x4 w; w.x = pack2(a[0], a[1]); w.y = pack2(a[2], a[3]); w.z = pack2(b[0], b[1]); w.w = pack2(b[2], b[3]); return w; }

struct EpiZ {
    static constexpr bool HAS_MID = false, ROWSCALE = true; static constexpr int MID1 = -1, MID2 = -1, NSEG = 1;
    bf16_t* zA; bf16_t* zG; float* gates; const float* rsq;
    __device__ __forceinline__ void mid(AccT&, const pg8::Unit&, int, int, int, int, int) const {}
    __device__ __forceinline__ void operator()(AccT& acc, const pg8::Unit& u, int wr, int wc, int fr, int fq, const LAS float* rs) const {
        int row0 = u.pm * 256 + wr * 64 + fr; asm volatile("" : "+v"(row0)); const int cb = wc * 32 + 8 * fq;
        if (u.pn < 52) {
            bf16_t* base = u.pn < 28 ? zA + u.pn * 256 : zG + (u.pn - 28) * 256; const int ld = u.pn < 28 ? NZA : NZG;
#pragma unroll
            for (int ai = 0; ai < 2; ++ai)
#pragma unroll
                for (int m = 0; m < 4; ++m) {
                    const int row = row0 + ai * 128 + m * 16; const float sc = rsqrtf(rs[ai * 128 + wr * 64 + m * 16 + fr] * (1.0f / D) + EPS);
#pragma unroll
                    for (int bj = 0; bj < 2; ++bj) {
                        f32x4 v0 = acc[ai][bj][m][0] * sc, v1 = acc[ai][bj][m][1] * sc;
                        if (u.pn >= 28) {
#pragma unroll
                            for (int i = 0; i < 4; ++i) { v0[i] = __expf(-v0[i]); v1[i] = __expf(-v1[i]); } }
                        *(u32x4*)(base + (size_t)row * ld + bj * 128 + cb) = pack8(v0, v1);
                    }
                }
        } else if (wc == 0 && fq == 0) {
#pragma unroll
            for (int ai = 0; ai < 2; ++ai)
#pragma unroll
                for (int m = 0; m < 4; ++m) {
                    const int row = row0 + ai * 128 + m * 16; const float sc = rsqrtf(rs[ai * 128 + wr * 64 + m * 16 + fr] * (1.0f / D) + EPS);
                    *(f32x4*)(gates + (size_t)row * 8) = acc[ai][0][m][0] * sc; *(f32x4*)(gates + (size_t)row * 8 + 4) = acc[ai][0][m][1] * sc;
                }
        }
    }
};
struct EpiMerge {
    static constexpr bool HAS_MID = true, ROWSCALE = false; static constexpr int MID1 = 8, MID2 = 24, NSEG = 3;
    const bf16_t* zG; bf16_t* mb;
    __device__ __forceinline__ void mid(AccT& acc, const pg8::Unit& u, int which, int wr, int wc, int fr, int fq) const {
        int row0 = u.pm * 256 + wr * 64 + fr; asm volatile("" : "+v"(row0)); const int cb = u.pn * 256 + wc * 32 + 8 * fq; const int onum = which * 2048, oden = onum + 2048;
#pragma unroll
        for (int ai = 0; ai < 2; ++ai) {
            u32x4 gn[4][2], gd[4][2];
#pragma unroll
            for (int m = 0; m < 4; ++m)
#pragma unroll
                for (int bj = 0; bj < 2; ++bj) { const bf16_t* zr = zG + (size_t)(row0 + ai * 128 + m * 16) * NZG + cb + bj * 128; gn[m][bj] = *(const u32x4*)(zr + onum); gd[m][bj] = *(const u32x4*)(zr + oden); }
#pragma unroll
            for (int m = 0; m < 4; ++m)
#pragma unroll
                for (int bj = 0; bj < 2; ++bj)
#pragma unroll
                    for (int q = 0; q < 4; ++q) {
                        const float r0 = (1.0f + lo16(gd[m][bj][q])) * __builtin_amdgcn_rcpf(1.0f + lo16(gn[m][bj][q])), r1 = (1.0f + hi16(gd[m][bj][q])) * __builtin_amdgcn_rcpf(1.0f + hi16(gn[m][bj][q]));
                        acc[ai][bj][m][q >> 1][(q & 1) * 2] *= r0; acc[ai][bj][m][q >> 1][(q & 1) * 2 + 1] *= r1;
                    }
        }
    }
    __device__ __forceinline__ void operator()(AccT& acc, const pg8::Unit& u, int wr, int wc, int fr, int fq, const LAS float* rs) const {
        int row0 = u.pm * 256 + wr * 64 + fr; asm volatile("" : "+v"(row0)); const int cb = u.pn * 256 + wc * 32 + 8 * fq;
#pragma unroll
        for (int ai = 0; ai < 2; ++ai) {
            u32x4 gd[4][2];
#pragma unroll
            for (int m = 0; m < 4; ++m)
#pragma unroll
                for (int bj = 0; bj < 2; ++bj) gd[m][bj] = *(const u32x4*)(zG + (size_t)(row0 + ai * 128 + m * 16) * NZG + 4096 + cb + bj * 128);
#pragma unroll
            for (int m = 0; m < 4; ++m)
#pragma unroll
                for (int bj = 0; bj < 2; ++bj) {
                    const int row = row0 + ai * 128 + m * 16, col = cb + bj * 128; const u32x4 g = gd[m][bj];
                    f32x4 v0 = acc[ai][bj][m][0], v1 = acc[ai][bj][m][1];
                    v0[0] *= __builtin_amdgcn_rcpf(1.0f + lo16(g[0])); v0[1] *= __builtin_amdgcn_rcpf(1.0f + hi16(g[0])); v0[2] *= __builtin_amdgcn_rcpf(1.0f + lo16(g[1])); v0[3] *= __builtin_amdgcn_rcpf(1.0f + hi16(g[1]));
                    v1[0] *= __builtin_amdgcn_rcpf(1.0f + lo16(g[2])); v1[1] *= __builtin_amdgcn_rcpf(1.0f + hi16(g[2])); v1[2] *= __builtin_amdgcn_rcpf(1.0f + lo16(g[3])); v1[3] *= __builtin_amdgcn_rcpf(1.0f + hi16(g[3]));
                    *(u32x4*)(mb + (size_t)row * D + col) = pack8(v0, v1);
                }
        }
    }
};
struct EpiResid {
    static constexpr bool HAS_MID = false, ROWSCALE = false; static constexpr int MID1 = -1, MID2 = -1, NSEG = 1;
    float* h; bf16_t* hb; float* rsqn;
    __device__ __forceinline__ void mid(AccT&, const pg8::Unit&, int, int, int, int, int) const {}
    __device__ __forceinline__ void operator()(AccT& acc, const pg8::Unit& u, int wr, int wc, int fr, int fq, const LAS float* rs) const {
        int row0 = u.pm * 256 + wr * 64 + fr; asm volatile("" : "+v"(row0)); const int cb = u.pn * 256 + wc * 32 + 8 * fq, lane = fr + 16 * fq;
#pragma unroll
        for (int ai = 0; ai < 2; ++ai) {
            f32x4 hv[4][2][2];
#pragma unroll
            for (int m = 0; m < 4; ++m)
#pragma unroll
                for (int bj = 0; bj < 2; ++bj) { const float* hp = h + (size_t)(row0 + ai * 128 + m * 16) * D + cb + bj * 128; hv[m][bj][0] = *(const f32x4*)hp; hv[m][bj][1] = *(const f32x4*)(hp + 4); }
#pragma unroll
            for (int m = 0; m < 4; ++m) {
                const int row = row0 + ai * 128 + m * 16; float ss = 0.f;
#pragma unroll
                for (int bj = 0; bj < 2; ++bj) {
                    const int col = cb + bj * 128; float* hp = h + (size_t)row * D + col;
                    const f32x4 o0 = hv[m][bj][0] + acc[ai][bj][m][0], o1 = hv[m][bj][1] + acc[ai][bj][m][1];
                    *(f32x4*)hp = o0; *(f32x4*)(hp + 4) = o1;
                    *(u32x4*)(hb + (size_t)row * D + col) = pack8(o0, o1);
                    ss += o0[0] * o0[0] + o0[1] * o0[1] + o0[2] * o0[2] + o0[3] * o0[3] + o1[0] * o1[0] + o1[1] * o1[1] + o1[2] * o1[2] + o1[3] * o1[3];
                }
                ss += shx(ss, 16, lane); ss += shx(ss, 32, lane);
                if (fq == 0) atomicAdd(rsqn + row, ss);
            }
        }
    }
};
struct EpiUp {
    static constexpr bool HAS_MID = false, ROWSCALE = true; static constexpr int MID1 = -1, MID2 = -1, NSEG = 1;
    bf16_t* z2; const float* rsq;
    __device__ __forceinline__ void mid(AccT&, const pg8::Unit&, int, int, int, int, int) const {}
    __device__ __forceinline__ void operator()(AccT& acc, const pg8::Unit& u, int wr, int wc, int fr, int fq, const LAS float* rs) const {
        int row0 = u.pm * 256 + wr * 64 + fr; asm volatile("" : "+v"(row0)); const int cb = u.pn * 256 + wc * 32 + 8 * fq;
#pragma unroll
        for (int ai = 0; ai < 2; ++ai)
#pragma unroll
            for (int m = 0; m < 4; ++m) {
                const int row = row0 + ai * 128 + m * 16; const float sc = rsqrtf(rs[ai * 128 + wr * 64 + m * 16 + fr] * (1.0f / D) + EPS);
#pragma unroll
                for (int bj = 0; bj < 2; ++bj) *(u32x4*)(z2 + (size_t)row * NUP + cb + bj * 128) = pack8(acc[ai][bj][m][0] * sc, acc[ai][bj][m][1] * sc);
            }
    }
};

template <int LDA, int LDB, int M, int N, int K, class Epi>
__device__ __forceinline__ void run_gemm(int wv, LAS unsigned char* lds, const bf16_t* A, const bf16_t* Bt, const Epi& E) {
    pg8::Gemm g; g.A = A; g.Bt = Bt;
    pg8::StaticOrder S; S.init(M, N, (int)gridDim.x, opaque_bid());
    pg8::gemm_phase<Epi, LDA, LDB, K>(wv, lds, g, S, E);
}

__device__ __forceinline__ void convert_weight(int wv, const float* __restrict__ src, int ldsrc, int Ksrc, bf16_t* dst, int ldd, int koff, int ntn, const float* kscale, int mode, LAS float* tile, int pidx, int pcnt) {
    const int tid = opaque_tid(wv); const int ntk = Ksrc / 128; const int total = ntn * ntk; const int G = pcnt;
    const int kk0 = tid >> 4, n4 = (tid & 15) * 4;
    f32x4 v[4]; float ks[4];
    auto prefetch = [&](int t) {
        const int tn = t % ntn, tk = t / ntn; const int n0 = tn * 64, k0 = tk * 128;
        int scol = n0, nvalid = 64;
        if (mode == 1) { if (n0 < 5632) scol = n0; else if (n0 < 13312) scol = n0 + 8; else if (n0 == 13312) { scol = 5632; nvalid = 8; } else { scol = 0; nvalid = 0; } }
#pragma unroll
        for (int i = 0; i < 4; ++i) { const int kk = kk0 + i * 32; v[i] = (f32x4){0.f, 0.f, 0.f, 0.f};
            if (n4 < nvalid) v[i] = *(const f32x4*)(src + (size_t)(k0 + kk) * ldsrc + scol + n4);
            ks[i] = kscale ? kscale[k0 + kk] : 1.0f; }
    };
    int t = pidx; int buf = 0;
    if (t < total) prefetch(t);
    for (; t < total; t += G) {
        LAS float* tl = tile + buf * (128 * 65);
#pragma unroll
        for (int i = 0; i < 4; ++i) { const int kk = kk0 + i * 32;
            tl[kk * 65 + n4 + 0] = v[i][0] * ks[i]; tl[kk * 65 + n4 + 1] = v[i][1] * ks[i]; tl[kk * 65 + n4 + 2] = v[i][2] * ks[i]; tl[kk * 65 + n4 + 3] = v[i][3] * ks[i]; }
        lds_barrier();
        const int tn = t % ntn, tk = t / ntn; const int n0 = tn * 64, k0 = tk * 128;
        if (t + G < total) prefetch(t + G);
        { const int n = tid >> 3, k16 = (tid & 7) * 16; u32x4 w0, w1;
          w0.x = pack2(tl[(k16 + 0) * 65 + n], tl[(k16 + 1) * 65 + n]); w0.y = pack2(tl[(k16 + 2) * 65 + n], tl[(k16 + 3) * 65 + n]);
          w0.z = pack2(tl[(k16 + 4) * 65 + n], tl[(k16 + 5) * 65 + n]); w0.w = pack2(tl[(k16 + 6) * 65 + n], tl[(k16 + 7) * 65 + n]);
          w1.x = pack2(tl[(k16 + 8) * 65 + n], tl[(k16 + 9) * 65 + n]); w1.y = pack2(tl[(k16 + 10) * 65 + n], tl[(k16 + 11) * 65 + n]);
          w1.z = pack2(tl[(k16 + 12) * 65 + n], tl[(k16 + 13) * 65 + n]); w1.w = pack2(tl[(k16 + 14) * 65 + n], tl[(k16 + 15) * 65 + n]);
          bf16_t* dp = dst + (size_t)(n0 + n) * ldd + koff + k0 + k16; *(u32x4*)dp = w0; *(u32x4*)(dp + 8) = w1; }
        buf ^= 1;
    }
    __syncthreads();
}
__device__ __forceinline__ void convert_layer(int wv, PP P, int L, int mask, LAS float* tile, int pidx, int pcnt) {
    unsigned char* ws = P->ws; unsigned char* dob = (unsigned char*)P->out;
    if (mask & 1) convert_weight(wv, P->w_in + (size_t)L * D * DIN, DIN, D, (bf16_t*)(ws + WS_WIN), D, 0, NZ / 64, P->norm_mix + L * D, 1, tile, pidx, pcnt);
    if (mask & 2) {
        bf16_t* wbr = (bf16_t*)(dob + DO_WBR);
        convert_weight(wv, P->w_br_a + (size_t)L * 512 * D, D, 512, wbr, D, 0, D / 64, nullptr, 0, tile, pidx, pcnt);
        convert_weight(wv, P->w_br_m + (size_t)L * 1024 * D, D, 1024, wbr, D, 512, D / 64, nullptr, 0, tile, pidx, pcnt);
        convert_weight(wv, P->w_br_d + (size_t)L * 512 * D, D, 512, wbr, D, 1536, D / 64, nullptr, 0, tile, pidx, pcnt);
    }
    if (mask & 4) convert_weight(wv, P->w_out + (size_t)L * D * D, D, D, (bf16_t*)(dob + DO_WOUT), D, 0, D / 64, nullptr, 0, tile, pidx, pcnt);
    if (mask & 8) convert_weight(wv, P->w_up + (size_t)L * D * NUP, NUP, D, (bf16_t*)(dob + DO_WUP), D, 0, NUP / 64, P->norm_ffn + L * D, 0, tile, pidx, pcnt);
    if (mask & 16) convert_weight(wv, P->w_down + (size_t)L * DFF * D, D, DFF, (bf16_t*)(ws + WS_WDOWN), DFF, 0, D / 64, nullptr, 0, tile, pidx, pcnt);
}

__device__ __forceinline__ void init_phase(int wv, PP P) {
    float* hp = (float*)(P->ws + WS_HP); bf16_t* hb = (bf16_t*)((unsigned char*)P->out + DO_HB); float* rsq = (float*)(P->ws + WS_RSQ); float* hsq = (float*)(P->ws + WS_HSQ);
    const int tid = opaque_tid(wv), w = tid >> 6, lane = tid & 63;
    for (int row = blockIdx.x * 8 + w; row < MP; row += gridDim.x * 8) {
        const int b = row / LP, pp = row % LP;
        const float* src = pp < PADN ? nullptr : (pp < LEADR ? P->meta + (size_t)(pp - PADN) * D : P->x + ((size_t)b * SEQ + (pp - LEADR)) * D);
        float ss = 0.f;
#pragma unroll
        for (int i = 0; i < 8; ++i) {
            const int c = (i * 64 + lane) * 4; f32x4 v = (f32x4){0.f, 0.f, 0.f, 0.f}; if (src) v = *(const f32x4*)(src + c);
            *(f32x4*)(hp + (size_t)row * D + c) = v; u32x2 o; o.x = pack2(v[0], v[1]); o.y = pack2(v[2], v[3]); *(u32x2*)(hb + (size_t)row * D + c) = o;
            ss += v[0] * v[0] + v[1] * v[1] + v[2] * v[2] + v[3] * v[3];
        }
#pragma unroll
        for (int o = 1; o < 64; o <<= 1) ss += shx(ss, o, lane);
        if (lane == 0) rsq[row] = ss;
    }
    for (int i = blockIdx.x * 512 + tid; i < 4 * MP; i += gridDim.x * 512) rsq[MP + i] = 0.f;
    for (int i = blockIdx.x * 512 + tid; i < 8 * MP; i += gridDim.x * 512) hsq[i] = 0.f;
}

__device__ __forceinline__ void conva_phase(int wv, PP P, int L) {
    const bf16_t* zA = (const bf16_t*)(P->ws + WS_Z); bf16_t* cat = (bf16_t*)((unsigned char*)P->out + DO_HB); const float* cw = P->conv_a + (size_t)L * 3 * 512;
    const int total = MP * 64;
    for (int idx = opaque_bid() * 512 + opaque_tid(wv); idx < total; idx += gridDim.x * 512) {
        const int row = idx >> 6, c = (idx & 63) * 8; const int pp = row % LP; u32x4 o = zero4();
        if (pp >= PADN) {
            float y[8];
#pragma unroll
            for (int i = 0; i < 8; ++i) y[i] = 0.f;
#pragma unroll
            for (int j = 0; j < 3; ++j) {
                const bf16_t* zr = zA + (size_t)(row - 2 + j) * NZA; const u32x4 ax = *(const u32x4*)(zr + ZA_AX + c), ac = *(const u32x4*)(zr + ZA_AC + c);
                const f32x4 w0 = *(const f32x4*)(cw + j * 512 + c), w1 = *(const f32x4*)(cw + j * 512 + c + 4);
#pragma unroll
                for (int q = 0; q < 4; ++q) { const float wa = q < 2 ? w0[q * 2] : w1[(q - 2) * 2], wb = q < 2 ? w0[q * 2 + 1] : w1[(q - 2) * 2 + 1];
                    y[2 * q] += wa * lo16(ax[q]) * lo16(ac[q]); y[2 * q + 1] += wb * hi16(ax[q]) * hi16(ac[q]); }
            }
            const u32x4 ab = *(const u32x4*)(zA + (size_t)row * NZA + ZA_AB + c);
#pragma unroll
            for (int q = 0; q < 4; ++q) o[q] = pack2(y[2 * q] * lo16(ab[q]), y[2 * q + 1] * hi16(ab[q]));
        }
        *(u32x4*)(cat + (size_t)row * D + c) = o;
    }
}

constexpr int ML_QS = 0, ML_KS = 33792, ML_CB = 67584, ML_VS = 92928, ML_VW = 98048, ML_PB = 105216, ML_SC = 114432;
__device__ __forceinline__ void mlstm_phase(int wv, PP P, int L, LAS unsigned char* lds) {
    const int tid = opaque_tid(wv), w = __builtin_amdgcn_readfirstlane(tid >> 6), lane = tid & 63, fr = lane & 15, fq = lane >> 4;
    const bf16_t* zA = (const bf16_t*)(P->ws + WS_Z); const float* gates = (const float*)(P->ws + WS_GATES);
    bf16_t* cat = (bf16_t*)((unsigned char*)P->out + DO_HB); float* hsq = (float*)(P->ws + WS_HSQ) + (size_t)L * MP * 4;
    LAS float* sc_a = (LAS float*)(lds + ML_SC); LAS float* sc_M = sc_a + 64; LAS float* sc_b = sc_a + 128; LAS float* sc_wk = sc_a + 192; LAS float* sc_rs = sc_a + 256; LAS float* sc_nq = sc_a + 384;
    LAS bf16_t* PB = (LAS bf16_t*)(lds + ML_PB); LAS bf16_t* CB = (LAS bf16_t*)(lds + ML_CB);
    const int mt = w >> 1, ntp = (w & 1) * 2, et = w & 1;
    const int trq = (lane >> 2) & 3, trp = lane & 3;
    const unsigned ldsb = (unsigned)(size_t)lds;
    const unsigned tr_k = ldsb + ML_KS + (8 * fq + trq) * 528 + (2 * w * 16 + 4 * trp) * 2;
    const unsigned tr_vw = ldsb + ML_VW + (8 * fq + trq) * 112 + (4 * trp) * 2;
    const unsigned tr_vs = ldsb + ML_VS + (8 * fq + trq) * 80 + (et * 16 + 4 * trp) * 2;
    f32x4* gsc = (f32x4*)(P->ws + WS_GSC) + (size_t)opaque_bid() * 34 * 64;
    for (int item = opaque_bid(); item < 256; item += gridDim.x) {
        const int b = item >> 5, h = (item >> 3) & 3, e0 = (item & 7) * 32;
        const float bi = P->b_if[L * 8 + h], bfg = P->b_if[L * 8 + 4 + h];
        __syncthreads();
        for (int i = tid; i < (25344 + 5120 + 7168) / 4; i += 512) ((LAS unsigned*)(lds + ML_CB))[i] = 0u;
        for (int c = w; c < 33; c += 8) {
            const size_t rr = (size_t)b * LP + (size_t)c * 64; const int t = lane; const bool valid = (c * 64 + t) >= PADN;
            const float gi = gates[(rr + t) * 8 + h] + bi, gf = gates[(rr + t) * 8 + 4 + h] + bfg;
            const float li = valid ? gi : -INFINITY;
            const float lf = valid ? (fminf(gf, 0.f) - log1pf(__expf(-fabsf(gf)))) : 0.f;
            float bc = lf;
#pragma unroll
            for (int o = 1; o < 64; o <<= 1) { const float y = shup(bc, o, lane); if (lane >= o) bc += y; }
            const float a = li - bc; float mx = a;
#pragma unroll
            for (int o = 1; o < 64; o <<= 1) { const float y = shup(mx, o, lane); if (lane >= o) mx = fmaxf(mx, y); }
            gsc[c * 64 + t] = (f32x4){bc, a, mx, 0.f};
        }
        f32x4 Cacc[3][2];
#pragma unroll
        for (int a = 0; a < 3; ++a)
#pragma unroll
            for (int c = 0; c < 2; ++c) Cacc[a][c] = (f32x4){0.f, 0.f, 0.f, 0.f};
        float m_prev = 0.f;
        u32x4 qreg[4], kreg[4], vreg; f32x4 greg = (f32x4){0.f, 0.f, 0.f, 0.f};
        auto fetch = [&](int cc) {
            const size_t rr = (size_t)b * LP + (size_t)cc * 64;
#pragma unroll
            for (int i = 0; i < 4; ++i) { const int id = tid + i * 512, t = id >> 5, d8 = (id & 31) * 8;
                qreg[i] = *(const u32x4*)(zA + (rr + t) * NZA + ZA_MQ + h * 256 + d8); kreg[i] = *(const u32x4*)(zA + (rr + t) * NZA + ZA_MK + h * 256 + d8); }
            if (tid < 256) { const int s = tid >> 2, e8 = (tid & 3) * 8; vreg = *(const u32x4*)(zA + (rr + s) * NZA + ZA_MV + h * 256 + e0 + e8); }
            if (w == 7) greg = gsc[cc * 64 + lane];
        };
        __syncthreads();
        fetch(0);
        for (int c = 0; c < 33; ++c) {
            const size_t r0 = (size_t)b * LP + (size_t)c * 64;
#pragma unroll
            for (int i = 0; i < 4; ++i) { const int id = tid + i * 512, t = id >> 5, d8 = (id & 31) * 8;
                *(LAS u32x4*)(lds + ML_QS + t * 528 + d8 * 2) = qreg[i]; *(LAS u32x4*)(lds + ML_KS + t * 528 + d8 * 2) = kreg[i]; }
            if (tid < 256) { const int s = tid >> 2, e8 = (tid & 3) * 8; *(LAS u32x4*)(lds + ML_VS + s * 80 + e8 * 2) = vreg; }
            if (w == 7) {
                const int t = lane; const float bc = greg[0], a = greg[1]; const float Mt = fmaxf(greg[2], m_prev); const float M63 = shidx(Mt, 63);
                sc_a[t] = a; sc_M[t] = Mt; sc_b[t] = bc; sc_wk[t] = __expf(a - M63) * 0.0625f; sc_nq[64 + t] = greg[3];
            }
            lds_barrier();
            if (c + 1 < 33) fetch(c + 1);
            const float M63 = sc_M[63], b63 = sc_b[63]; const float gs = __expf(m_prev - M63), m_new = b63 + M63;
            { const int sr = tid >> 3, e4 = (tid & 7) * 4; const u32x2 v = *(const LAS u32x2*)(lds + ML_VS + sr * 80 + e4 * 2); const float wk = sc_wk[sr];
              u32x2 o; o.x = pack2(lo16(v.x) * wk, hi16(v.x) * wk); o.y = pack2(lo16(v.y) * wk, hi16(v.y) * wk); *(LAS u32x2*)(lds + ML_VW + sr * 112 + e4 * 2) = o;
              if ((tid & 7) == 0) *(LAS bf16_t*)(lds + ML_VW + sr * 112 + 64) = f2bf(wk); }
            bf16x8 aq[8];
#pragma unroll
            for (int kk = 0; kk < 8; ++kk) aq[kk] = *(const LAS bf16x8*)(lds + ML_QS + (mt * 16 + fr) * 528 + (kk * 32 + fq * 8) * 2);
            f32x4 s0 = (f32x4){0.f, 0.f, 0.f, 0.f}, s1 = s0, ov = s0, ovn = s0;
#pragma unroll
            for (int kk = 0; kk < 8; ++kk) {
                const bf16x8 b0 = *(const LAS bf16x8*)(lds + ML_KS + (ntp * 16 + fr) * 528 + (kk * 32 + fq * 8) * 2);
                const bf16x8 b1 = *(const LAS bf16x8*)(lds + ML_KS + ((ntp + 1) * 16 + fr) * 528 + (kk * 32 + fq * 8) * 2);
                const bf16x8 bq = *(const LAS bf16x8*)(lds + ML_CB + (et * 16 + fr) * 528 + (kk * 32 + fq * 8) * 2);
                s0 = __builtin_amdgcn_mfma_f32_16x16x32_bf16(aq[kk], b0, s0, 0, 0, 0);
                s1 = __builtin_amdgcn_mfma_f32_16x16x32_bf16(aq[kk], b1, s1, 0, 0, 0);
                ov = __builtin_amdgcn_mfma_f32_16x16x32_bf16(aq[kk], bq, ov, 0, 0, 0);
            }
            if (et == 0) {
#pragma unroll
                for (int kk = 0; kk < 8; ++kk) { const bf16x8 bn = *(const LAS bf16x8*)(lds + ML_CB + (32 + fr) * 528 + (kk * 32 + fq * 8) * 2);
                    ovn = __builtin_amdgcn_mfma_f32_16x16x32_bf16(aq[kk], bn, ovn, 0, 0, 0); }
                if (fr == 0) {
#pragma unroll
                    for (int j = 0; j < 4; ++j) sc_nq[mt * 16 + fq * 4 + j] = ovn[j]; }
            }
            {
                float rs[4] = {0.f, 0.f, 0.f, 0.f};
#pragma unroll
                for (int q = 0; q < 2; ++q) {
                    const int s = (ntp + q) * 16 + fr; const float as = sc_a[s];
#pragma unroll
                    for (int j = 0; j < 4; ++j) { const int t = mt * 16 + fq * 4 + j; const float wgt = (s <= t) ? __expf(as - sc_M[t]) * 0.0625f : 0.f;
                        const float pv = (q == 0 ? s0[j] : s1[j]) * wgt; rs[j] += pv; PB[t * 72 + s] = f2bf(pv); }
                }
#pragma unroll
                for (int j = 0; j < 4; ++j) { float v = row_sum16(rs[j]);
                    if (fr == 0) sc_rs[(w & 1) * 64 + mt * 16 + fq * 4 + j] = v; }
            }
            lds_barrier();
            float g[4];
#pragma unroll
            for (int j = 0; j < 4; ++j) { g[j] = __expf(m_prev - sc_M[mt * 16 + fq * 4 + j]); ov[j] *= g[j]; }
            {
                u32x2 v0 = trr(tr_vs), v1 = trr(tr_vs + 4 * 80), v2 = trr(tr_vs + 32 * 80), v3 = trr(tr_vs + 36 * 80);
                trw4(v0, v1, v2, v3);
                const bf16x8 a0 = *(const LAS bf16x8*)(lds + ML_PB + (mt * 16 + fr) * 144 + (fq * 8) * 2);
                const bf16x8 a1 = *(const LAS bf16x8*)(lds + ML_PB + (mt * 16 + fr) * 144 + (32 + fq * 8) * 2);
                ov = __builtin_amdgcn_mfma_f32_16x16x32_bf16(a0, mk8(v0, v1), ov, 0, 0, 0);
                ov = __builtin_amdgcn_mfma_f32_16x16x32_bf16(a1, mk8(v2, v3), ov, 0, 0, 0);
            }
#pragma unroll
            for (int j = 0; j < 4; ++j) {
                const int t = mt * 16 + fq * 4 + j; const float den = g[j] * sc_nq[t] + sc_rs[t] + sc_rs[64 + t];
                const float dn = fmaxf(fabsf(den), __expf(-(sc_b[t] + sc_M[t]))); const float hv = ov[j] * __builtin_amdgcn_rcpf(dn);
                cat[(r0 + t) * D + 512 + h * 256 + e0 + et * 16 + fr] = f2bf(hv);
                float sq = row_sum16(hv * hv);
                if (fr == 0) atomicAdd(hsq + (r0 + t) * 4 + h, sq);
            }
#pragma unroll
            for (int e2 = 0; e2 < 3; ++e2)
#pragma unroll
                for (int di = 0; di < 2; ++di) Cacc[e2][di] *= gs;
#pragma unroll
            for (int kk = 0; kk < 2; ++kk) {
                u32x2 k0 = trr(tr_k + kk * 32 * 528), k1 = trr(tr_k + kk * 32 * 528 + 4 * 528), k2 = trr(tr_k + kk * 32 * 528 + 32), k3 = trr(tr_k + kk * 32 * 528 + 4 * 528 + 32);
                trw4(k0, k1, k2, k3);
                const bf16x8 kb0 = mk8(k0, k1), kb1 = mk8(k2, k3);
#pragma unroll
                for (int e2 = 0; e2 < 3; ++e2) {
                    u32x2 a0 = trr(tr_vw + kk * 32 * 112 + e2 * 32), a1 = trr(tr_vw + kk * 32 * 112 + 4 * 112 + e2 * 32);
                    trw2(a0, a1);
                    const bf16x8 af = mk8(a0, a1);
                    Cacc[e2][0] = __builtin_amdgcn_mfma_f32_16x16x32_bf16(af, kb0, Cacc[e2][0], 0, 0, 0);
                    Cacc[e2][1] = __builtin_amdgcn_mfma_f32_16x16x32_bf16(af, kb1, Cacc[e2][1], 0, 0, 0);
                }
            }
#pragma unroll
            for (int e2 = 0; e2 < 3; ++e2)
#pragma unroll
                for (int di = 0; di < 2; ++di) {
                    const int dt = 2 * w + di; const f32x4 cc = Cacc[e2][di];
                    if (e2 < 2) {
#pragma unroll
                        for (int j = 0; j < 4; ++j) CB[(e2 * 16 + fq * 4 + j) * 264 + dt * 16 + fr] = f2bf(cc[j]);
                    } else if (fq == 0) CB[32 * 264 + dt * 16 + fr] = f2bf(cc[0]);
                }
            m_prev = m_new;
            lds_barrier();
        }
    }
}

constexpr int AT_K = 0, AT_V = 34816;
__device__ __forceinline__ void attn_phase(int wv, PP P, int L, LAS unsigned char* lds) {
    const int tid = opaque_tid(wv), w = __builtin_amdgcn_readfirstlane(tid >> 6), lane = tid & 63, fr = lane & 15, fq = lane >> 4;
    const bf16_t* zA = (const bf16_t*)(P->ws + WS_Z); bf16_t* cat = (bf16_t*)((unsigned char*)P->out + DO_HB);
    const float lam_init = 0.8f - 0.6f * expf(-0.3f * (float)L);
    float lam;
    { const float* lf = P->da_lambda + (size_t)L * 256; float x = lf[lane] * lf[64 + lane], y = lf[128 + lane] * lf[192 + lane];
#pragma unroll
      for (int o = 1; o < 64; o <<= 1) { x += shx(x, o, lane); y += shx(y, o, lane); }
      lam = expf(x) - expf(y) + lam_init; }
    const int trq = (lane >> 2) & 3, trp = lane & 3; const unsigned ldsb = (unsigned)(size_t)lds;
    for (int it = opaque_bid(); it < 544; it += gridDim.x) {
        int j, bh;
        if (it < 256) { j = 16 - (it >> 5); bh = it & 31; } else if (it < 512) { const int r = 511 - it; j = 8 - (r >> 5); bh = r & 31; } else { j = 0; bh = it - 512; }
        const int b = bh >> 2, h = bh & 3; const int q0 = j * 128 - 64; const bool wact = (j > 0) || (w >= 4);
        const size_t qrow = (size_t)b * LP + (wact ? q0 + w * 16 + fr : 0);
        bf16x8 qf[2][2];
#pragma unroll
        for (int m = 0; m < 2; ++m)
#pragma unroll
            for (int kk = 0; kk < 2; ++kk) qf[m][kk] = *(const bf16x8*)(zA + qrow * NZA + ZA_DQ + h * 128 + m * 64 + kk * 32 + fq * 8);
        f32x4 O[2][8]; float mrun[2], lrun[2];
#pragma unroll
        for (int m = 0; m < 2; ++m) {
#pragma unroll
            for (int e = 0; e < 8; ++e) O[m][e] = (f32x4){0.f, 0.f, 0.f, 0.f};
            mrun[m] = -INFINITY; lrun[m] = 0.f;
        }
        const int ktmax = 2 * j; const int my_last = !wact ? -1 : ((j >= 1 && w < 4) ? ktmax - 1 : ktmax);
        u32x4 kpre[2], vpre[2];
        auto fetchkv = [&](int kk_t) {
            const size_t kr = (size_t)b * LP + (size_t)kk_t * 64;
#pragma unroll
            for (int i = 0; i < 2; ++i) { const int id = tid + i * 512, s = id >> 4, c8 = (id & 15) * 8; kpre[i] = *(const u32x4*)(zA + (kr + s) * NZA + ZA_DK + h * 128 + c8); }
#pragma unroll
            for (int i = 0; i < 2; ++i) { const int id = tid + i * 512, s = id >> 4, c8 = (id & 15) * 8; vpre[i] = *(const u32x4*)(zA + (kr + s) * NZA + ZA_DV + h * 128 + c8); }
        };
        fetchkv(0);
        lds_barrier();
        for (int kt = 0; kt <= ktmax; ++kt) {
            const int kbuf = AT_K + (kt & 1) * 17408, vbuf = AT_V + (kt & 1) * 17408;
#pragma unroll
            for (int i = 0; i < 2; ++i) { const int id = tid + i * 512, s = id >> 4, c8 = (id & 15) * 8; *(LAS u32x4*)(lds + kbuf + s * 272 + c8 * 2) = kpre[i]; *(LAS u32x4*)(lds + vbuf + s * 272 + c8 * 2) = vpre[i]; }
            lds_barrier();
            if (kt < ktmax) fetchkv(kt + 1);
            if (kt <= my_last) {
                bf16x8 pf[2][2];
#pragma unroll
                for (int m = 0; m < 2; ++m) {
                    f32x4 sa[4];
#pragma unroll
                    for (int nt = 0; nt < 4; ++nt) { sa[nt] = (f32x4){0.f, 0.f, 0.f, 0.f};
#pragma unroll
                        for (int kk = 0; kk < 2; ++kk) { const bf16x8 kf = *(const LAS bf16x8*)(lds + kbuf + (nt * 16 + fr) * 272 + (m * 64 + kk * 32 + fq * 8) * 2);
                            sa[nt] = __builtin_amdgcn_mfma_f32_16x16x32_bf16(kf, qf[m][kk], sa[nt], 0, 0, 0); } }
                    float mx = -INFINITY;
#pragma unroll
                    for (int nt = 0; nt < 4; ++nt)
#pragma unroll
                        for (int q = 0; q < 4; ++q) { const bool kv = (kt > 0) || (nt * 16 + fq * 4 + q >= 48); sa[nt][q] = kv ? sa[nt][q] * 0.125f : -INFINITY; mx = fmaxf(mx, sa[nt][q]); }
                    mx = fmaxf(mx, shx(mx, 16, lane)); mx = fmaxf(mx, shx(mx, 32, lane));
                    const float mnew = fmaxf(mrun[m], mx); const float alpha = __expf(mrun[m] - mnew); mrun[m] = mnew;
                    float rsum = 0.f;
#pragma unroll
                    for (int nt = 0; nt < 4; ++nt)
#pragma unroll
                        for (int q = 0; q < 4; ++q) { sa[nt][q] = __expf(sa[nt][q] - mnew); rsum += sa[nt][q]; }
                    rsum += shx(rsum, 16, lane); rsum += shx(rsum, 32, lane);
                    lrun[m] = lrun[m] * alpha + rsum;
#pragma unroll
                    for (int e = 0; e < 8; ++e) O[m][e] *= alpha;
#pragma unroll
                    for (int kp = 0; kp < 2; ++kp) { u32x4 t; t.x = pack2(sa[2 * kp][0], sa[2 * kp][1]); t.y = pack2(sa[2 * kp][2], sa[2 * kp][3]); t.z = pack2(sa[2 * kp + 1][0], sa[2 * kp + 1][1]); t.w = pack2(sa[2 * kp + 1][2], sa[2 * kp + 1][3]);
                        pf[m][kp] = __builtin_bit_cast(bf16x8, t); }
                }
                const unsigned trv = ldsb + vbuf + (4 * fq + trq) * 272 + (4 * trp) * 2;
#pragma unroll
                for (int kp = 0; kp < 2; ++kp) {
                    u32x2 vl[8], vh[8];
#pragma unroll
                    for (int e = 0; e < 8; ++e) { vl[e] = trr(trv + (32 * kp) * 272 + e * 32); vh[e] = trr(trv + (32 * kp + 16) * 272 + e * 32); }
                    trw4(vl[0], vl[1], vl[2], vl[3]); trw4(vl[4], vl[5], vl[6], vl[7]); trw4(vh[0], vh[1], vh[2], vh[3]); trw4(vh[4], vh[5], vh[6], vh[7]);
#pragma unroll
                    for (int e = 0; e < 8; ++e) { const bf16x8 vf = mk8(vl[e], vh[e]);
                        O[0][e] = __builtin_amdgcn_mfma_f32_16x16x32_bf16(vf, pf[0][kp], O[0][e], 0, 0, 0);
                        O[1][e] = __builtin_amdgcn_mfma_f32_16x16x32_bf16(vf, pf[1][kp], O[1][e], 0, 0, 0); }
                }
            }
        }
        const float* dn = P->da_norm + (size_t)L * 128;
        const float i0 = __builtin_amdgcn_rcpf(lrun[0]), i1 = lam * __builtin_amdgcn_rcpf(lrun[1]); float ss = 0.f;
#pragma unroll
        for (int e = 0; e < 8; ++e) { O[0][e] = O[0][e] * i0 - O[1][e] * i1; ss += O[0][e][0] * O[0][e][0] + O[0][e][1] * O[0][e][1] + O[0][e][2] * O[0][e][2] + O[0][e][3] * O[0][e][3]; }
        ss += shx(ss, 16, lane); ss += shx(ss, 32, lane);
        const int pos = q0 + w * 16 + fr; const float r = (pos < PADN) ? 0.f : rsqrtf(ss * (1.0f / 128.0f) + EPS) * (1.0f - lam_init);
#pragma unroll
        for (int e = 0; e < 8; ++e) { const f32x4 g4 = *(const f32x4*)(dn + e * 16 + fq * 4); u32x2 o; o.x = pack2(O[0][e][0] * r * g4[0], O[0][e][1] * r * g4[1]); o.y = pack2(O[0][e][2] * r * g4[2], O[0][e][3] * r * g4[3]);
            if (pos < PADN) { o.x = 0u; o.y = 0u; }
            if (wact) *(u32x2*)(cat + ((size_t)b * LP + pos) * D + 1536 + h * 128 + e * 16 + fq * 4) = o; }
    }
}

__device__ __forceinline__ void fin_phase(int wv, PP P, int L) {
    const bf16_t* zA = (const bf16_t*)(P->ws + WS_Z); bf16_t* cat = (bf16_t*)((unsigned char*)P->out + DO_HB); const float* hsq = (const float*)(P->ws + WS_HSQ) + (size_t)L * MP * 4;
    const float* mn = P->ml_norm + (size_t)L * 1024; constexpr int total = MP * 128;
    const int nthr = gridDim.x * 512;
    for (int idx0 = opaque_bid() * 512 + opaque_tid(wv); idx0 < total; idx0 += 4 * nthr) {
        u32x4 raw[4], og[4]; float rr[4];
#pragma unroll
        for (int k = 0; k < 4; ++k) { const int idx = idx0 + k * nthr; if (idx < total) { const int row = idx >> 7, c = (idx & 127) * 8;
            raw[k] = *(const u32x4*)(cat + (size_t)row * D + 512 + c); og[k] = *(const u32x4*)(zA + (size_t)row * NZA + ZA_MO + c); rr[k] = hsq[(size_t)row * 4 + (c >> 8)]; } }
#pragma unroll
        for (int k = 0; k < 4; ++k) { const int idx = idx0 + k * nthr; if (idx < total) { const int row = idx >> 7, c = (idx & 127) * 8;
            const float r = rsqrtf(rr[k] * (1.0f / 256.0f) + EPS); const f32x4 w0 = *(const f32x4*)(mn + c), w1 = *(const f32x4*)(mn + c + 4); u32x4 o;
            o.x = pack2(lo16(raw[k].x) * r * w0[0] * sigm(lo16(og[k].x)), hi16(raw[k].x) * r * w0[1] * sigm(hi16(og[k].x)));
            o.y = pack2(lo16(raw[k].y) * r * w0[2] * sigm(lo16(og[k].y)), hi16(raw[k].y) * r * w0[3] * sigm(hi16(og[k].y)));
            o.z = pack2(lo16(raw[k].z) * r * w1[0] * sigm(lo16(og[k].z)), hi16(raw[k].z) * r * w1[1] * sigm(hi16(og[k].z)));
            o.w = pack2(lo16(raw[k].w) * r * w1[2] * sigm(lo16(og[k].w)), hi16(raw[k].w) * r * w1[3] * sigm(hi16(og[k].w)));
            *(u32x4*)(cat + (size_t)row * D + 512 + c) = o; } }
    }
}

__device__ __forceinline__ void act_phase(int wv, PP P, int L) {
    bf16_t* z2 = (bf16_t*)(P->ws + WS_Z); const float* cw = P->conv_ffn + (size_t)L * 3 * DFF; const float* cb = P->conv_ffn_b + (size_t)L * DFF;
    constexpr int NCG = DFF / 8, NCH = 176, RPC = 96;
    const int id = opaque_bid() * 512 + opaque_tid(wv);
    if (id >= NCG * NCH) return;
    const int c = (id % NCG) * 8, ch = id / NCG; const int r0 = ch * RPC, r1 = (r0 + RPC < MP) ? r0 + RPC : MP;
    float w0[8], w1[8], w2[8], bs[8];
    { const f32x4 a0 = *(const f32x4*)(cw + c), a1 = *(const f32x4*)(cw + c + 4), b0 = *(const f32x4*)(cw + DFF + c), b1 = *(const f32x4*)(cw + DFF + c + 4), c0 = *(const f32x4*)(cw + 2 * DFF + c), c1 = *(const f32x4*)(cw + 2 * DFF + c + 4), d0 = *(const f32x4*)(cb + c), d1 = *(const f32x4*)(cb + c + 4);
#pragma unroll
      for (int i = 0; i < 4; ++i) { w0[i] = a0[i]; w0[4 + i] = a1[i]; w1[i] = b0[i]; w1[4 + i] = b1[i]; w2[i] = c0[i]; w2[4 + i] = c1[i]; bs[i] = d0[i]; bs[4 + i] = d1[i]; } }
    u32x4 am2 = zero4(), am1 = zero4();
    if (r0 >= 2) { am2 = *(const u32x4*)(z2 + (size_t)(r0 - 2) * NUP + c); am1 = *(const u32x4*)(z2 + (size_t)(r0 - 1) * NUP + c); }
    for (int row = r0; row < r1; row += 4) {
        u32x4 av[4], bv[4];
#pragma unroll
        for (int k = 0; k < 4; ++k) { av[k] = __builtin_nontemporal_load((const u32x4*)(z2 + (size_t)(row + k) * NUP + c)); bv[k] = __builtin_nontemporal_load((const u32x4*)(z2 + (size_t)(row + k) * NUP + DFF + c)); }
#pragma unroll
        for (int k = 0; k < 4; ++k) {
            const u32x4 a0 = av[k], bb = bv[k]; float y[8];
#pragma unroll
            for (int q = 0; q < 4; ++q) {
                y[2 * q] = bs[2 * q] + w0[2 * q] * lo16(am2[q]) + w1[2 * q] * lo16(am1[q]) + w2[2 * q] * lo16(a0[q]);
                y[2 * q + 1] = bs[2 * q + 1] + w0[2 * q + 1] * hi16(am2[q]) + w1[2 * q + 1] * hi16(am1[q]) + w2[2 * q + 1] * hi16(a0[q]);
            }
            u32x4 o;
#pragma unroll
            for (int q = 0; q < 4; ++q) o[q] = pack2(gelu_as(y[2 * q]) * lo16(bb[q]), gelu_as(y[2 * q + 1]) * hi16(bb[q]));
            *(u32x4*)(z2 + (size_t)(row + k) * NUP + DFF + c) = o;
            am2 = am1; am1 = a0;
        }
    }
}

__device__ __forceinline__ void final_phase(int wv, PP P) {
    const float* hp = (const float*)(P->ws + WS_HP); const float* rsq = (const float*)(P->ws + WS_RSQ) + (size_t)4 * MP;
    const int tid = opaque_tid(wv), w = tid >> 6, lane = tid & 63;
    for (int orow = blockIdx.x * 8 + w; orow < NB * SEQ; orow += gridDim.x * 8) {
        const int b = orow / SEQ, s = orow % SEQ; const size_t row = (size_t)b * LP + LEADR + s; const float r = rsqrtf(rsq[row] * (1.0f / D) + EPS);
#pragma unroll
        for (int i = 0; i < 8; ++i) { const int c = (i * 64 + lane) * 4; const f32x4 v = *(const f32x4*)(hp + row * D + c), g = *(const f32x4*)(P->norm_f + c);
            *(f32x4*)(P->out + (size_t)orow * D + c) = v * g * r; }
    }
}


#define XB_TMO      128
#define XB_XCNT(j)  (256  + 64 * (j))
#define XB_XSUB(j)  (1280 + 64 * (j))
#define XB_XGEN(j)  (2304 + 64 * (j))
#define XB_TOP      3328
#define XB_TOPGEN   3392
#define XB_SPIN_CAP (1u << 18)
__device__ __forceinline__ unsigned xb_ld(unsigned* p)              { return __hip_atomic_load(p, __ATOMIC_RELAXED, __HIP_MEMORY_SCOPE_AGENT); }
__device__ __forceinline__ unsigned xb_add(unsigned* p, unsigned v) { return __hip_atomic_fetch_add(p, v, __ATOMIC_RELAXED, __HIP_MEMORY_SCOPE_AGENT); }
__device__ __forceinline__ unsigned xb_xcc_id() { return (unsigned)__builtin_amdgcn_s_getreg((3 << 11) | 20) & 0xFu; }
#define XB_SPIN(cond, bar) do { unsigned _sp = 0; while (cond) { __builtin_amdgcn_s_sleep(1); \
    if ((++_sp & 255u) == 0u) { if (xb_ld(&(bar)[XB_TMO])) break; if (_sp > XB_SPIN_CAP) { atomicAdd(&(bar)[XB_TMO], 1u); break; } } } } while (0)
__device__ __forceinline__ void xcd_barrier_complete(unsigned* bar, unsigned x, unsigned& nloc, unsigned& nx) {
    const unsigned G = gridDim.x * gridDim.y * gridDim.z;
    unsigned sum, cnt, mine, sp = 0u;
    for (;;) {
        sum = 0u; cnt = 0u; mine = 0u;
#pragma unroll
        for (unsigned j = 0; j < 16; ++j) { const unsigned c = xb_ld(&bar[XB_XCNT(j)]); sum += c; cnt += (c > 0u) ? 1u : 0u; mine = (j == x) ? c : mine; }
        if (sum == G) break;
        __builtin_amdgcn_s_sleep(1);
        if ((++sp & 255u) == 0u) { if (xb_ld(&bar[XB_TMO])) break; if (sp > XB_SPIN_CAP) { atomicAdd(&bar[XB_TMO], 1u); break; } }
    }
    nloc = mine > 0u ? mine : 1u; nx = cnt > 0u ? cnt : 1u;
}
__device__ __forceinline__ void gbar_post(int wv, LAS unsigned char* lds) {
    const int tid = opaque_tid(wv); unsigned* bar = (unsigned*)(get_params()->ws + WS_BAR);
    if (tid == 0) { volatile LAS unsigned* st = (volatile LAS unsigned*)(lds + LDS_ST); st[0] = 0u; st[1] = 0u;
        (void)xb_add(&bar[XB_XCNT(xb_xcc_id())], 1u); }
    __syncthreads();
}
__device__ __forceinline__ void gbar(int wv, LAS unsigned char* lds) {
    asm volatile("s_waitcnt vmcnt(0)" ::: "memory");
    __syncthreads();
    const int tid = opaque_tid(wv); unsigned* bar = (unsigned*)(get_params()->ws + WS_BAR);
    if (tid == 0) {
        volatile LAS unsigned* st = (volatile LAS unsigned*)(lds + LDS_ST); const unsigned x = xb_xcc_id();
        __builtin_amdgcn_s_waitcnt(0);
        unsigned nloc = st[0], nx = st[1];
        if (nloc == 0u) { xcd_barrier_complete(bar, x, nloc, nx); st[0] = nloc; st[1] = nx; }
        const unsigned old = xb_add(&bar[XB_XSUB(x)], 1u);
        const unsigned gen = old / nloc;
        if (old + 1u == (gen + 1u) * nloc) {
            __builtin_amdgcn_fence(__ATOMIC_RELEASE, "agent");
            asm volatile("s_waitcnt vmcnt(0)" ::: "memory");
            const unsigned og = xb_add(&bar[XB_TOP], 1u);
            const unsigned tg = og / nx;
            if (og + 1u == (tg + 1u) * nx) xb_add(&bar[XB_TOPGEN], 1u);
            else XB_SPIN(xb_ld(&bar[XB_TOPGEN]) == tg, bar);
            __builtin_amdgcn_fence(__ATOMIC_ACQUIRE, "agent");
            xb_add(&bar[XB_XGEN(x)], 1u);
            asm volatile("s_waitcnt vmcnt(0)" ::: "memory");
        } else {
            XB_SPIN(xb_ld(&bar[XB_XGEN(x)]) == gen, bar);
            __builtin_amdgcn_fence(__ATOMIC_ACQUIRE, "agent");
            asm volatile("s_waitcnt vmcnt(0)" ::: "memory");
        }
    }
    __syncthreads();
}

__device__ __forceinline__ void fill_convert(int wv, LAS unsigned char* lds, int nunits, int L, int mask) {
    const int G = (int)gridDim.x, extra = nunits % G, bid = opaque_bid();
    if (extra != 0 && bid >= extra) convert_layer(wv, get_params(), L, mask, (LAS float*)lds, bid - extra, G - extra);
}
__device__ __forceinline__ void ph_gemm_in(int wv, LAS unsigned char* lds, int L) {
    PP P = get_params(); unsigned char* ws = P->ws; unsigned char* dob = (unsigned char*)P->out;
    EpiZ e; e.zA = (bf16_t*)(ws + WS_Z); e.zG = (bf16_t*)(ws + WS_ZG); e.gates = (float*)(ws + WS_GATES); e.rsq = (float*)(ws + WS_RSQ) + (size_t)(2 * L) * MP;
    run_gemm<D, D, MP, NZ, D>(wv, lds, (const bf16_t*)(dob + DO_HB), (const bf16_t*)(ws + WS_WIN), e);
    if (L == 0) fill_convert(wv, lds, (MP / 256) * (NZ / 256), 0, 2 | 4);
}
__device__ __forceinline__ void ph_gemm_merge(int wv, LAS unsigned char* lds, int L) {
    PP P = get_params(); unsigned char* ws = P->ws; unsigned char* dob = (unsigned char*)P->out;
    EpiMerge e; e.zG = (const bf16_t*)(ws + WS_ZG); e.mb = (bf16_t*)(ws + WS_Z);
    run_gemm<D, D, MP, D, D>(wv, lds, (const bf16_t*)(dob + DO_HB), (const bf16_t*)(dob + DO_WBR), e);
    fill_convert(wv, lds, (MP / 256) * (D / 256), L, L == 0 ? (8 | 16) : 16);
}
__device__ __forceinline__ void ph_gemm_out(int wv, LAS unsigned char* lds, int L) {
    PP P = get_params(); unsigned char* ws = P->ws; unsigned char* dob = (unsigned char*)P->out;
    EpiResid e; e.h = (float*)(ws + WS_HP); e.hb = (bf16_t*)(dob + DO_HB); e.rsqn = (float*)(ws + WS_RSQ) + (size_t)(2 * L + 1) * MP;
    run_gemm<D, D, MP, D, D>(wv, lds, (const bf16_t*)(ws + WS_Z), (const bf16_t*)(dob + DO_WOUT), e);
    if (L == 0) fill_convert(wv, lds, (MP / 256) * (D / 256), 1, 1);
}
__device__ __forceinline__ void ph_gemm_up(int wv, LAS unsigned char* lds, int L) {
    PP P = get_params(); unsigned char* ws = P->ws; unsigned char* dob = (unsigned char*)P->out;
    EpiUp e; e.z2 = (bf16_t*)(ws + WS_Z); e.rsq = (const float*)(ws + WS_RSQ) + (size_t)(2 * L + 1) * MP;
    run_gemm<D, D, MP, NUP, D>(wv, lds, (const bf16_t*)(dob + DO_HB), (const bf16_t*)(dob + DO_WUP), e);
    if (L == 0) fill_convert(wv, lds, (MP / 256) * (NUP / 256), 1, 2 | 4);
}
__device__ __forceinline__ void ph_gemm_down(int wv, LAS unsigned char* lds, int L) {
    PP P = get_params(); unsigned char* ws = P->ws; unsigned char* dob = (unsigned char*)P->out;
    EpiResid e; e.h = (float*)(ws + WS_HP); e.hb = (bf16_t*)(dob + DO_HB); e.rsqn = (float*)(ws + WS_RSQ) + (size_t)(2 * L + 2) * MP;
    run_gemm<NUP, DFF, MP, D, DFF>(wv, lds, (const bf16_t*)(ws + WS_Z) + DFF, (const bf16_t*)(ws + WS_WDOWN), e);
    if (L == 0) fill_convert(wv, lds, (MP / 256) * (D / 256), 1, 8);
}

__global__ void __launch_bounds__(512, 2) fwd_megakernel(Params p_unused) {
    extern __shared__ __attribute__((aligned(16))) unsigned char smem[];
    LAS unsigned char* lds = (LAS unsigned char*)smem;
    cg::grid_group grid = cg::this_grid();
    const int wv = __builtin_amdgcn_readfirstlane((int)threadIdx.x >> 6);
    gbar_post(wv, lds);
    convert_layer(wv, get_params(), 0, 1, (LAS float*)lds, opaque_bid(), (int)gridDim.x);
    init_phase(wv, get_params());
    if (get_params()->ws == nullptr) grid.sync();
    gbar(wv, lds);
#pragma unroll
    for (int L = 0; L < 2; ++L) {
        ph_gemm_in(wv, lds, L);
        gbar(wv, lds);
        conva_phase(wv, get_params(), L);
        mlstm_phase(wv, get_params(), L, lds);
        attn_phase(wv, get_params(), L, lds);
        gbar(wv, lds);
        fin_phase(wv, get_params(), L);
        gbar(wv, lds);
        ph_gemm_merge(wv, lds, L);
        gbar(wv, lds);
        ph_gemm_out(wv, lds, L);
        gbar(wv, lds);
        ph_gemm_up(wv, lds, L);
        gbar(wv, lds);
        act_phase(wv, get_params(), L);
        gbar(wv, lds);
        ph_gemm_down(wv, lds, L);
        gbar(wv, lds);
    }
    final_phase(wv, get_params());
}

extern "C" void kernel_launch(void* const* d_in, const int* in_sizes, int n_in, void* d_out, int out_size, void* d_ws, size_t ws_size, hipStream_t stream) {
    static int grid_blocks = 0;
    if (grid_blocks == 0) {
        if (n_in != 19 || ws_size < WS_END) { fprintf(stderr, "kernel_launch: unexpected inputs (n_in %d, ws %zu, need %zu)\n", n_in, ws_size, (size_t)WS_END); grid_blocks = -1; return; }
        int dev = 0, cus = 0, per_cu = 0;
        hipGetDevice(&dev); hipDeviceGetAttribute(&cus, hipDeviceAttributeMultiprocessorCount, dev);
        if (hipFuncSetAttribute((const void*)fwd_megakernel, hipFuncAttributeMaxDynamicSharedMemorySize, LDS_BYTES) != hipSuccess) { fprintf(stderr, "kernel_launch: hipFuncSetAttribute failed\n"); grid_blocks = -1; return; }
        hipOccupancyMaxActiveBlocksPerMultiprocessor(&per_cu, (const void*)fwd_megakernel, 512, LDS_BYTES);
        if (per_cu < 1) per_cu = 1;
        grid_blocks = cus * per_cu;
        if (grid_blocks > 256) grid_blocks = 256;
    }
    if (grid_blocks < 0) return;
    Params p{};
    const float** pp = (const float**)&p;
    for (int i = 0; i < 19; ++i) pp[i] = (const float*)d_in[i];
    p.out = (float*)d_out; p.ws = (unsigned char*)d_ws;
    (void)hipMemsetAsync((char*)d_ws + WS_BAR, 0, 3456 * 4, stream);
    void* args[] = {&p};
    hipError_t e = hipLaunchCooperativeKernel((const void*)fwd_megakernel, dim3(grid_blocks), dim3(512), args, LDS_BYTES, stream);
    if (e != hipSuccess) fprintf(stderr, "cooperative launch failed: %s (grid %d)\n", hipGetErrorString(e), grid_blocks);
}
```
